# Optimizing an MI355X kernel written in HIP

```python
import math
import jax, jax.numpy as jnp
from jax import lax
import numpy as np

D_MODEL = 2048
BATCH = 32
SEQ = 256
DEPTH = 4
DEC_BATCH = 8
DEC_SEQ = 2048
PAST_LEN = 256

GRID_W = 64
N_HEADS = 16
KV_HEADS = 4
HEAD_DIM = 128
D_ATTN = N_HEADS * HEAD_DIM
D_KV = KV_HEADS * HEAD_DIM
D_CONV = D_MODEL // 2
CONV_W = 3
D_FF = -(-8 * D_MODEL // (3 * 256)) * 256
Q_BLOCK = 128
ROPE_THETA = 10000.0
EPS = 1e-6
IN_COLS = D_ATTN + 2 * D_KV + 3 * D_CONV + 2 * D_MODEL

kernel_name = "hybrid_conv_gqa_prefix_dit_step"


def rms_norm(x, gain):
    xf = x.astype(jnp.float32)
    y = xf * lax.rsqrt(jnp.mean(xf * xf, axis=-1, keepdims=True) + EPS)
    return (y * gain.astype(jnp.float32)).astype(x.dtype)


def adaln(cond, w_ada, b_ada):
    m = jnp.einsum('...d,de->...e', jax.nn.silu(cond), w_ada) + b_ada
    return jnp.split(m[..., None, :], 6, axis=-1)


def axial_rope(n_tokens):
    rows = n_tokens // GRID_W
    row = jnp.repeat(jnp.arange(rows, dtype=jnp.float32), GRID_W)
    col = jnp.tile(jnp.arange(GRID_W, dtype=jnp.float32), rows)
    n_freq = HEAD_DIM // 4
    inv = ROPE_THETA ** (-jnp.arange(n_freq, dtype=jnp.float32) / n_freq)
    ang = jnp.concatenate([row[:, None] * inv, col[:, None] * inv], axis=-1)
    return jnp.cos(ang), jnp.sin(ang)


def apply_rope(x, cos, sin):
    xf = x.astype(jnp.float32)
    x1, x2 = jnp.split(xf, 2, axis=-1)
    c = cos[None, :, None, :]
    s = sin[None, :, None, :]
    return jnp.concatenate([x1 * c - x2 * s, x2 * c + x1 * s], axis=-1).astype(x.dtype)


def blocked_attention(q, k, v):
    B, S, H, hd = q.shape
    G = H // KV_HEADS
    nb = S // Q_BLOCK
    qb = q.reshape(B, nb, Q_BLOCK, KV_HEADS, G, hd).transpose(1, 0, 2, 3, 4, 5)
    kf = k.astype(jnp.float32)
    vf = v.astype(jnp.float32)
    scale = 1.0 / math.sqrt(hd)

    def one_block(qblk):
        s = jnp.einsum('bqkgd,bskd->bkgqs', qblk.astype(jnp.float32) * scale, kf)
        p = jax.nn.softmax(s, axis=-1)
        return jnp.einsum('bkgqs,bskd->bqkgd', p, vf).astype(q.dtype)

    o = lax.map(one_block, qb)
    return o.transpose(1, 0, 2, 3, 4, 5).reshape(B, S, H * hd)


def short_conv(xc, w, b):
    xp = jnp.pad(xc, ((0, 0), (1, 1), (0, 0)))
    return xp[:, :-2] * w[0] + xp[:, 1:-1] * w[1] + xp[:, 2:] * w[2] + b


def trunk_layer(x, cond, ctx_kv, rope, p):
    (w_ada, b_ada, g1, w_in, q_gain, k_gain, conv_w, conv_b,
     w_a, w_b, w_o, g2, w_gate, w_up, w_down) = p
    B, S, _ = x.shape
    sh1, sc1, gt1, sh2, sc2, gt2 = adaln(cond, w_ada, b_ada)

    h = rms_norm(x, g1) * (1 + sc1) + sh1
    proj = h @ w_in
    cuts = [D_ATTN, D_ATTN + D_KV, D_ATTN + 2 * D_KV,
            D_ATTN + 2 * D_KV + D_CONV, D_ATTN + 2 * D_KV + 2 * D_CONV,
            D_ATTN + 2 * D_KV + 3 * D_CONV, D_ATTN + 2 * D_KV + 3 * D_CONV + D_MODEL]
    q, k, v, cv_b, cv_c, cv_x, gate_a, gate_b = jnp.split(proj, cuts, axis=-1)

    q = rms_norm(q.reshape(B, S, N_HEADS, HEAD_DIM), q_gain)
    k = rms_norm(k.reshape(B, S, KV_HEADS, HEAD_DIM), k_gain)
    v = v.reshape(B, S, KV_HEADS, HEAD_DIM)
    if rope is None:
        keys, vals = k, v
    else:
        q = apply_rope(q, *rope)
        k = apply_rope(k, *rope)
        keys = jnp.concatenate([k, ctx_kv[0]], axis=1)
        vals = jnp.concatenate([v, ctx_kv[1]], axis=1)
    o_attn = blocked_attention(q, keys, vals)

    y_conv = cv_b * short_conv(cv_c * cv_x, conv_w, conv_b)

    merged = jax.nn.sigmoid(gate_a) * (y_conv @ w_a) + jax.nn.sigmoid(gate_b) * (o_attn @ w_b)
    x = x + gt1 * (merged @ w_o)

    h2 = rms_norm(x, g2) * (1 + sc2) + sh2
    x = x + gt2 * ((jax.nn.silu(h2 @ w_gate) * (h2 @ w_up)) @ w_down)
    return x, (k, v)


def setup_inputs(seed: int = 0) -> dict:
    key = jax.random.key(seed)
    ks = jax.random.split(key, 24)
    f32 = jnp.float32

    def nrm(k, shape, scale=1.0):
        return jax.random.normal(k, shape, f32) * scale

    kv_shape = (DEC_BATCH, DEPTH, PAST_LEN, KV_HEADS, HEAD_DIM)
    return {
        "x_prompt": nrm(ks[0], (BATCH, SEQ, D_MODEL)),
        "x_sample": nrm(ks[1], (DEC_BATCH, DEC_SEQ, D_MODEL)),
        "cache_k": nrm(ks[2], kv_shape),
        "cache_v": nrm(ks[3], kv_shape),
        "c": nrm(ks[4], (DEC_BATCH, D_MODEL)),
        "c_ctx": nrm(ks[5], (D_MODEL,)),
        "w_ada": nrm(ks[6], (DEPTH, D_MODEL, 6 * D_MODEL), 0.5 * D_MODEL ** -0.5),
        "b_ada": nrm(ks[7], (DEPTH, 6 * D_MODEL), 0.02),
        "norm1": 1.0 + nrm(ks[8], (DEPTH, D_MODEL), 0.02),
        "w_in": nrm(ks[9], (DEPTH, D_MODEL, IN_COLS), D_MODEL ** -0.5),
        "q_gain": 1.0 + nrm(ks[10], (DEPTH, HEAD_DIM), 0.02),
        "k_gain": 1.0 + nrm(ks[11], (DEPTH, HEAD_DIM), 0.02),
        "conv_w": nrm(ks[12], (DEPTH, CONV_W, D_CONV), CONV_W ** -0.5),
        "conv_b": nrm(ks[13], (DEPTH, D_CONV), 0.02),
        "w_a": nrm(ks[14], (DEPTH, D_CONV, D_MODEL), D_CONV ** -0.5),
        "w_b": nrm(ks[15], (DEPTH, D_ATTN, D_MODEL), D_ATTN ** -0.5),
        "w_o": nrm(ks[16], (DEPTH, D_MODEL, D_MODEL), D_MODEL ** -0.5),
        "norm2": 1.0 + nrm(ks[17], (DEPTH, D_MODEL), 0.02),
        "w_gate": nrm(ks[18], (DEPTH, D_MODEL, D_FF), D_MODEL ** -0.5),
        "w_up": nrm(ks[19], (DEPTH, D_MODEL, D_FF), D_MODEL ** -0.5),
        "w_down": nrm(ks[20], (DEPTH, D_FF, D_MODEL), D_FF ** -0.5),
        "norm_f": 1.0 + nrm(ks[21], (D_MODEL,), 0.02),
    }


def reference(x_prompt, x_sample, cache_k, cache_v, c, c_ctx,
              w_ada, b_ada, norm1, w_in, q_gain, k_gain, conv_w, conv_b,
              w_a, w_b, w_o, norm2, w_gate, w_up, w_down, norm_f):
    rope = axial_rope(x_sample.shape[1])
    ctx = x_prompt
    lat = x_sample
    new_k = []
    new_v = []
    for l in range(DEPTH):
        p = (w_ada[l], b_ada[l], norm1[l], w_in[l], q_gain[l], k_gain[l],
             conv_w[l], conv_b[l], w_a[l], w_b[l], w_o[l], norm2[l],
             w_gate[l], w_up[l], w_down[l])
        ctx, (k_ctx, v_ctx) = trunk_layer(ctx, c_ctx, None, None, p)
        new_k.append(k_ctx)
        new_v.append(v_ctx)
        lat, _ = trunk_layer(lat, c, (cache_k[:, l], cache_v[:, l]), rope, p)
    y_prompt = rms_norm(ctx, norm_f)
    y_sample = rms_norm(lat, norm_f)
    new_cache_k = jnp.stack(new_k, axis=1)
    new_cache_v = jnp.stack(new_v, axis=1)
    return (y_prompt, y_sample, new_cache_k, new_cache_v)
```

```cpp
#include <hip/hip_runtime.h>
#include <cstdio>
#include <cstdint>
namespace pg8 {
#define PG8_LAS __attribute__((address_space(3)))
typedef unsigned short bf16_t;
typedef short bf16x8 __attribute__((ext_vector_type(8)));
typedef float f32x4 __attribute__((ext_vector_type(4)));
typedef unsigned u32x4 __attribute__((ext_vector_type(4)));
constexpr int BM = 256, BK = 64, HALF = 128, HTB = HALF * BK * 2  , STAGE_BYTES = 8 * HTB, NXCD = 8, WGM = 8;

__host__ __device__ __forceinline__ int lds_byte(int r, int c) { const int st = (r >> 4) * 2 + (c >> 5), rr = r & 15, cc = c & 31, ob = rr * 64 + cc * 2; return st * 1024 + (ob ^ (((ob >> 9) & 1) << 5)); }
__host__ __device__ __forceinline__ void stage_rc(int b, int& R, int& C) { const int st = b / 1024, sb = b % 1024, swz = sb ^ (((sb >> 9) & 1) << 5); R = (st >> 1) * 16 + swz / 64; C = (st & 1) * 32 + (swz % 64) / 2; }
__host__ __device__ __forceinline__ int perm32(int rho) { const int n = rho >> 4, i = rho & 15; return 8 * (i >> 2) + 4 * n + (i & 3); }

struct Unit { int pm, pn; };
struct Gemm { const bf16_t* A; const bf16_t* Bt; int M, N, K; };

struct StaticOrder {
    int nM, nN, nwg, G, c;
    __host__ __device__ void init(int M, int N, int G_, int c_) { nM = M / BM; nN = N / BM; nwg = nM * nN; G = G_; c = c_; }
    __host__ __device__ bool next(int i, Unit& u) const {
        const long L = (long)i * G + c; if (L >= nwg) return false;
        int wgid = (int)L; { const int q = nwg / NXCD, r = nwg % NXCD, xcd = wgid % NXCD, off = wgid / NXCD; wgid = (xcd < r ? xcd * (q + 1) : r * (q + 1) + (xcd - r) * q) + off; }
        const int nig = WGM * nN, gid = wgid / nig, fm = gid * WGM, gsz = (nM - fm) < WGM ? (nM - fm) : WGM;
        u.pm = fm + ((wgid % nig) % gsz); u.pn = (wgid % nig) / gsz; return true;
    }
    __device__ __forceinline__ void a_ready(const Unit&) const {}
    __device__ __forceinline__ void done(const Unit&) const {}
};

__device__ __forceinline__ unsigned cvt_pk_bf16(float lo, float hi) { unsigned r; asm volatile("v_cvt_pk_bf16_f32 %0, %1, %2" : "=v"(r) : "v"(lo), "v"(hi)); return r; }
typedef float f32x2 __attribute__((ext_vector_type(2)));
__device__ __forceinline__ f32x2 gelu_pk(f32x2 v) {
    const f32x2 av = __builtin_elementwise_abs(v), d = av * 0.2316418882f + 1.0f;
    f32x2 t; t.x = __builtin_amdgcn_rcpf(d.x); t.y = __builtin_amdgcn_rcpf(d.y);
    f32x2 q = t * 0.5307027145f + (-0.7265760135f); q = q * t + 0.7107068705f; q = q * t + (-0.142248368f); q = q * t + 0.127414796f; q = q * t;
    const f32x2 s = (v * v) * (-0.72134752044f);
    f32x2 e; e.x = __builtin_amdgcn_exp2f(s.x); e.y = __builtin_amdgcn_exp2f(s.y);
    const f32x2 m = v * (q * e), r = v - m;
    f32x2 o; o.x = v.x < 0.f ? m.x : r.x; o.y = v.y < 0.f ? m.y : r.y; return o;
}

template <int ACT  > struct EpiBf16 {
    static constexpr bool PERM = true, AFTER_DRAIN = false; static_assert(ACT == 0 || ACT == 1, "EpiBf16: ACT is 0 (none) or 1 (gelu_pk)");
    bf16_t* O; int ldc; const float* bias; int split_cols; size_t split_stride; float scale0;
    __device__ __forceinline__ void operator()(const f32x4 (&acc)[2][2][4][2], const Unit& u, int wr, int wc, int fr, int fq) const {
        const int row0 = u.pm * BM + wr * 64 + fr; int colt = u.pn * BM; bf16_t* base = O;
        float sc = 1.f; if (split_cols) { const int t = colt / split_cols; base += (size_t)t * split_stride; colt -= t * split_cols; if (t == 0) sc = scale0; }
        const int col0 = colt + wc * 32 + 8 * fq, bcol0 = u.pn * BM + wc * 32 + 8 * fq;
        f32x4 bv[2][2];
#pragma unroll
        for (int bj = 0; bj < 2; ++bj)
#pragma unroll
            for (int n = 0; n < 2; ++n) bv[bj][n] = bias ? *(const f32x4*)(bias + bcol0 + bj * HALF + 4 * n) : (f32x4){0.f, 0.f, 0.f, 0.f};
#pragma unroll
        for (int ai = 0; ai < 2; ++ai)
#pragma unroll
            for (int m = 0; m < 4; ++m) { bf16_t* rowp = base + (size_t)(row0 + ai * HALF + m * 16) * ldc + col0;
#pragma unroll
                for (int bj = 0; bj < 2; ++bj) { f32x4 v0 = acc[ai][bj][m][0] + bv[bj][0], v1 = acc[ai][bj][m][1] + bv[bj][1];
                    if (ACT == 1) { f32x2 a = gelu_pk((f32x2){v0[0], v0[1]}), b = gelu_pk((f32x2){v0[2], v0[3]}), c = gelu_pk((f32x2){v1[0], v1[1]}), d = gelu_pk((f32x2){v1[2], v1[3]});
                        v0 = (f32x4){a.x, a.y, b.x, b.y}; v1 = (f32x4){c.x, c.y, d.x, d.y}; }
                    v0 = v0 * sc; v1 = v1 * sc; u32x4 w; w.x = cvt_pk_bf16(v0[0], v0[1]); w.y = cvt_pk_bf16(v0[2], v0[3]); w.z = cvt_pk_bf16(v1[0], v1[1]); w.w = cvt_pk_bf16(v1[2], v1[3]);
                    *(u32x4*)(rowp + bj * HALF) = w; } }
    }
};
struct EpiF32 {
    static constexpr bool PERM = false, AFTER_DRAIN = false;
    float* C; int ldc;
    __device__ __forceinline__ void operator()(const f32x4 (&acc)[2][2][4][2], const Unit& u, int wr, int wc, int fr, int fq) const {
        const int row0 = u.pm * BM + wr * 64 + fr, col0 = u.pn * BM + wc * 32 + 4 * fq;
#pragma unroll
        for (int ai = 0; ai < 2; ++ai)
#pragma unroll
            for (int m = 0; m < 4; ++m) { float* rowp = C + (size_t)(row0 + ai * HALF + m * 16) * ldc + col0;
#pragma unroll
                for (int bj = 0; bj < 2; ++bj)
#pragma unroll
                    for (int n = 0; n < 2; ++n) *(f32x4*)(rowp + bj * HALF + n * 16) = acc[ai][bj][m][n]; }
    }
};
template <class Epi, class Sched, bool ALIGN_EPI = false, bool SP2 = false>
__device__ __forceinline__ void gemm_phase(PG8_LAS unsigned char* lds, const Gemm g, const Sched& S, const Epi& E) {
    const int tid = threadIdx.x, wid = __builtin_amdgcn_readfirstlane(tid >> 6), lane = tid & 63, wr = wid >> 2, wc = wid & 3, fr = lane & 15, fq = lane >> 4;
    const int K = g.K, nt = K / BK;
    unsigned voffA[2], voffB[2];
#pragma unroll
    for (int i = 0; i < 2; ++i) { int R, C; stage_rc(tid * 16 + i * 8192, R, C); const int Rb = Epi::PERM ? ((R & ~31) + perm32(R & 31)) : R;
        voffA[i] = (unsigned)(R * K + C) * 2u; voffB[i] = (unsigned)(Rb * K + C) * 2u; }
    const size_t kstep = (size_t)(BK * 2);
    const size_t hstep = (size_t)HALF * K * 2;
    const size_t tstep = 2 * hstep;
    const unsigned ldsw = (unsigned)wid * 1024u;
    const int aoff = lds_byte(wr * 64 + fr, fq * 8), boff = lds_byte(wc * 32 + fr, fq * 8);
#define PG8_SA(b, h) (((b) * 2 + (h)) * HTB)
#define PG8_SB(b, h) ((4 + (b) * 2 + (h)) * HTB)
#define PG8_STAGE(bufoff, gbase, voff) do { _Pragma("unroll") for (int _i = 0; _i < 2; ++_i) \
        __builtin_amdgcn_global_load_lds((const unsigned*)((const char*)(gbase) + (voff)[_i]), (PG8_LAS unsigned*)(lds + (bufoff) + ldsw + _i * 8192), 16, 0, 0); } while (0)
#define PG8_LDA(dst, b, h) do { _Pragma("unroll") for (int m = 0; m < 4; ++m) _Pragma("unroll") for (int k = 0; k < 2; ++k) dst[m][k] = *(const PG8_LAS bf16x8*)(lds + PG8_SA(b, h) + aoff + m * 2048 + k * 1024); } while (0)
#define PG8_LDB(dst, b, h) do { _Pragma("unroll") for (int n = 0; n < 2; ++n) _Pragma("unroll") for (int k = 0; k < 2; ++k) dst[n][k] = *(const PG8_LAS bf16x8*)(lds + PG8_SB(b, h) + boff + n * 2048 + k * 1024); } while (0)
#define PG8_MMA(ai, bj, At, Bt) do { __builtin_amdgcn_s_setprio(1); _Pragma("unroll") for (int m = 0; m < 4; ++m) _Pragma("unroll") for (int n = 0; n < 2; ++n) _Pragma("unroll") for (int k = 0; k < 2; ++k) \
        acc[ai][bj][m][n] = __builtin_amdgcn_mfma_f32_16x16x32_bf16(Bt[n][k], At[m][k], acc[ai][bj][m][n], 0, 0, 0); __builtin_amdgcn_s_setprio(0); } while (0)
#define PG8_WAIT_V(n) asm volatile("s_waitcnt vmcnt(" #n ")" ::: "memory")
#define PG8_WAIT_L(n) asm volatile("s_waitcnt lgkmcnt(" #n ")" ::: "memory")
#define PG8_BAR __builtin_amdgcn_s_barrier()
#define PG8_SCHED __builtin_amdgcn_sched_barrier(0)
    Unit cur, nxt; int ui = 0;
    if (!S.next(0, cur)) return;
    f32x4 acc[2][2][4][2];
#pragma unroll
    for (int a = 0; a < 2; ++a)
#pragma unroll
        for (int b = 0; b < 2; ++b)
#pragma unroll
            for (int m = 0; m < 4; ++m)
#pragma unroll
                for (int n = 0; n < 2; ++n) acc[a][b][m][n] = (f32x4){0.f, 0.f, 0.f, 0.f};
    bf16x8 At[4][2], B0[2][2], B1[2][2];
    const char* cA = (const char*)g.A + (size_t)cur.pm * tstep; const char* cB = (const char*)g.Bt + (size_t)cur.pn * tstep;
    S.a_ready(cur);
    if constexpr (SP2) {
        PG8_STAGE(PG8_SB(0, 0), cB, voffB); PG8_STAGE(PG8_SB(0, 1), cB + hstep, voffB); PG8_STAGE(PG8_SA(0, 0), cA, voffA); PG8_STAGE(PG8_SA(0, 1), cA + hstep, voffA);
        if (wr == 1) PG8_BAR;
        PG8_WAIT_V(2); PG8_BAR;
        PG8_STAGE(PG8_SB(1, 0), cB + kstep, voffB); PG8_STAGE(PG8_SA(1, 0), cA + kstep, voffA); PG8_STAGE(PG8_SB(1, 1), cB + hstep + kstep, voffB);
        PG8_WAIT_V(6); PG8_BAR;
    } else {
        PG8_STAGE(PG8_SB(0, 0), cB, voffB); PG8_STAGE(PG8_SA(0, 0), cA, voffA); PG8_STAGE(PG8_SB(0, 1), cB + hstep, voffB); PG8_STAGE(PG8_SA(0, 1), cA + hstep, voffA);
        if (wr == 1) PG8_BAR;
        PG8_WAIT_V(4); PG8_BAR;
        PG8_STAGE(PG8_SB(1, 0), cB + kstep, voffB); PG8_STAGE(PG8_SA(1, 0), cA + kstep, voffA); PG8_STAGE(PG8_SB(1, 1), cB + hstep + kstep, voffB);
        PG8_WAIT_V(6); PG8_BAR;
    }
    for (;;) {
        const bool has_next = S.next(ui + 1, nxt);
        const char* nA = has_next ? (const char*)g.A + (size_t)nxt.pm * tstep : cA; const char* nB = has_next ? (const char*)g.Bt + (size_t)nxt.pn * tstep : cB;
        for (int t = 0; t < nt; t += 2) {
            const bool last = (t == nt - 2);
            const char* a1 = cA + (size_t)(t + 1) * kstep;
            const char* a2 = last ? nA : cA + (size_t)(t + 2) * kstep; const char* b2 = last ? nB : cB + (size_t)(t + 2) * kstep;
            const char* a3 = a2 + kstep; const char* b3 = b2 + kstep;
            if (last && has_next) S.a_ready(nxt);
            if constexpr (SP2) {
            PG8_LDB(B0, 0, 0); PG8_LDB(B1, 0, 1); PG8_SCHED; PG8_LDA(At, 0, 0); PG8_STAGE(PG8_SA(1, 1), a1 + hstep, voffA);
            PG8_WAIT_V(8); PG8_WAIT_L(0); PG8_BAR; PG8_MMA(0, 0, At, B0); PG8_MMA(0, 1, At, B1); PG8_BAR; PG8_SCHED;
            PG8_LDA(At, 0, 1); PG8_STAGE(PG8_SB(0, 0), b2, voffB); PG8_STAGE(PG8_SB(0, 1), b2 + hstep, voffB); PG8_STAGE(PG8_SA(0, 0), a2, voffA);
            PG8_WAIT_V(8); PG8_WAIT_L(0); PG8_BAR; PG8_MMA(1, 0, At, B0); PG8_MMA(1, 1, At, B1); PG8_BAR; PG8_SCHED;
            PG8_LDB(B0, 1, 0); PG8_LDB(B1, 1, 1); PG8_SCHED; PG8_LDA(At, 1, 0); PG8_STAGE(PG8_SA(0, 1), a2 + hstep, voffA);
            PG8_WAIT_V(8); PG8_WAIT_L(0); PG8_BAR; PG8_MMA(0, 0, At, B0); PG8_MMA(0, 1, At, B1); PG8_BAR; PG8_SCHED;
            PG8_LDA(At, 1, 1); PG8_STAGE(PG8_SB(1, 0), b3, voffB); PG8_STAGE(PG8_SB(1, 1), b3 + hstep, voffB); PG8_STAGE(PG8_SA(1, 0), a3, voffA);
            PG8_WAIT_V(8); PG8_WAIT_L(0); PG8_BAR; PG8_MMA(1, 0, At, B0); PG8_MMA(1, 1, At, B1); PG8_BAR; PG8_SCHED;
            } else {
            PG8_LDB(B0, 0, 0); PG8_SCHED; PG8_LDA(At, 0, 0); PG8_STAGE(PG8_SA(1, 1), a1 + hstep, voffA);
            PG8_WAIT_L(8); PG8_BAR; PG8_WAIT_L(0); PG8_MMA(0, 0, At, B0); PG8_BAR; PG8_SCHED;
            PG8_LDB(B1, 0, 1); PG8_STAGE(PG8_SB(0, 0), b2, voffB);
            PG8_BAR; PG8_WAIT_L(0); PG8_MMA(0, 1, At, B1); PG8_BAR;
            PG8_LDA(At, 0, 1); PG8_STAGE(PG8_SA(0, 0), a2, voffA);
            PG8_BAR; PG8_WAIT_L(0); PG8_MMA(1, 0, At, B0); PG8_BAR; PG8_SCHED;
            PG8_STAGE(PG8_SB(0, 1), b2 + hstep, voffB);
            PG8_WAIT_V(6); PG8_BAR; PG8_MMA(1, 1, At, B1); PG8_BAR;
            PG8_LDB(B0, 1, 0); PG8_SCHED; PG8_LDA(At, 1, 0); PG8_STAGE(PG8_SA(0, 1), a2 + hstep, voffA);
            PG8_WAIT_L(8); PG8_BAR; PG8_WAIT_L(0); PG8_MMA(0, 0, At, B0); PG8_BAR; PG8_SCHED;
            PG8_LDB(B1, 1, 1); PG8_STAGE(PG8_SB(1, 0), b3, voffB);
            PG8_BAR; PG8_WAIT_L(0); PG8_MMA(0, 1, At, B1); PG8_BAR;
            PG8_LDA(At, 1, 1); PG8_STAGE(PG8_SA(1, 0), a3, voffA);
            PG8_BAR; PG8_WAIT_L(0); PG8_MMA(1, 0, At, B0); PG8_BAR; PG8_SCHED;
            PG8_STAGE(PG8_SB(1, 1), b3 + hstep, voffB);
            PG8_WAIT_V(6); PG8_BAR; PG8_MMA(1, 1, At, B1); PG8_BAR;
            }
        }
        if constexpr (ALIGN_EPI) { if (wr == 0) PG8_BAR; }
        if constexpr (!Epi::AFTER_DRAIN) { E(acc, cur, wr, wc, fr, fq); S.done(cur); }
        if (!has_next) break;
#pragma unroll
        for (int a = 0; a < 2; ++a)
#pragma unroll
            for (int b = 0; b < 2; ++b)
#pragma unroll
                for (int m = 0; m < 4; ++m)
#pragma unroll
                    for (int n = 0; n < 2; ++n) acc[a][b][m][n] = (f32x4){0.f, 0.f, 0.f, 0.f};
        cur = nxt; cA = nA; cB = nB; ++ui;
        if constexpr (ALIGN_EPI) { if (wr == 1) PG8_BAR; }
    }
    PG8_WAIT_V(0);
    if constexpr (!ALIGN_EPI) { if (wr == 0) PG8_BAR; }
    PG8_BAR;
    if constexpr (Epi::AFTER_DRAIN) { E.fused(acc, cur, wr, wc, fr, fq, lds, wid, lane); S.done(cur); }
#undef PG8_SA
#undef PG8_SB
#undef PG8_STAGE
#undef PG8_LDA
#undef PG8_LDB
#undef PG8_MMA
#undef PG8_WAIT_V
#undef PG8_WAIT_L
#undef PG8_BAR
#undef PG8_SCHED
}
}
#define GAS __attribute__((address_space(1)))
#define LAS __attribute__((address_space(3)))
typedef unsigned short bf16;
typedef unsigned v4u __attribute__((ext_vector_type(4)));
typedef unsigned v2u __attribute__((ext_vector_type(2)));
typedef float f32x4 __attribute__((ext_vector_type(4)));
typedef short bf16x8 __attribute__((ext_vector_type(8)));

constexpr int DM = 2048, NCTX = 8192, NLAT = 16384, MTOK = 24576, DEPTH = 4;
constexpr int NH = 16, NKV = 4, HD = 128, DKV = 512, DCONV = 1024, DFF = 5632;
constexpr int NIN = 10240, NGU = 11264, NMOD = 9, ADA_N = 12288;
constexpr float EPS = 1e-6f;

constexpr size_t MiB = 1u << 20;
constexpr size_t WS_CTL = 0, CTL_ZERO_BYTES = 1 * MiB;
constexpr size_t WS_MODS = 1 * MiB;
constexpr size_t WS_ROPE = 3 * MiB;
constexpr size_t WS_PART = 4 * MiB;
constexpr size_t WS_KC = 18 * MiB, WS_VC = 26 * MiB;
constexpr size_t WS_W = 34 * MiB;
constexpr size_t W_LAYER = 126 * MiB, W_IN = 0, W_A = 40 * MiB, W_B = 44 * MiB, W_O = 52 * MiB, W_GU = 60 * MiB, W_D = 104 * MiB;
constexpr size_t WS_HB = 538 * MiB;
constexpr size_t WS_Q = 634 * MiB;
constexpr size_t WS_K = 730 * MiB, WS_V = 754 * MiB;
constexpr size_t WS_CVB = 778 * MiB;
constexpr size_t WS_U = 826 * MiB;
constexpr size_t WS_SA = 874 * MiB, WS_SB = 970 * MiB;
constexpr size_t WS_ACT = 634 * MiB;
constexpr size_t WS_TMP = 1066 * MiB;
constexpr size_t WS_C = 1258 * MiB;
constexpr size_t WS_END = 1434 * MiB;
constexpr size_t OUT_YS = (size_t)NCTX * DM, OUT_NK = (size_t)MTOK * DM, OUT_NV = OUT_NK + (size_t)32 * 4 * 256 * 512;

struct Params {
    const float *x_prompt, *x_sample, *cache_k, *cache_v, *c, *c_ctx, *w_ada, *b_ada, *norm1, *w_in, *q_gain, *k_gain, *conv_w, *conv_b,
                *w_a, *w_b, *w_o, *norm2, *w_gate, *w_up, *w_down, *norm_f;
    float* out; unsigned char* ws;
};

__device__ __forceinline__ unsigned f2bf(float f) { unsigned u = __builtin_bit_cast(unsigned, f); return (u + 0x7fffu + ((u >> 16) & 1u)) >> 16; }
__device__ __forceinline__ unsigned pk2(float lo, float hi) { return f2bf(lo) | (f2bf(hi) << 16); }
__device__ __forceinline__ float bf2f(unsigned b) { return __builtin_bit_cast(float, b << 16); }
__device__ __forceinline__ float bflo(unsigned w) { return __builtin_bit_cast(float, w << 16); }
__device__ __forceinline__ float bfhi(unsigned w) { return __builtin_bit_cast(float, w & 0xffff0000u); }
__device__ __forceinline__ float wave_sum(float v) {
#pragma unroll
    for (int o = 1; o < 64; o <<= 1) v += __shfl_xor(v, o);
    return v;
}
__device__ __forceinline__ float sigmoidf_(float v) { return 1.f / (1.f + __expf(-v)); }

__host__ __device__ __forceinline__ int c8_of_ph(int ph) { const int wc = ph >> 5, n = (ph >> 4) & 1, fq = (ph >> 2) & 3, j = ph & 3; return 32 * wc + 8 * fq + 4 * n + j; }
__host__ __device__ __forceinline__ int ph_of_c8(int c) { const int wc = c >> 5, fq = (c >> 3) & 3, n = (c >> 2) & 1, j = c & 3; return 32 * wc + 16 * n + 4 * fq + j; }
__host__ __device__ __forceinline__ int d_of_ph(int ph) { const int wc = ph >> 5, n = (ph >> 4) & 1, fq = (ph >> 2) & 3, j = ph & 3; return 16 * wc + 4 * fq + j + 64 * n; }
__host__ __device__ __forceinline__ int ph_of_d(int d) { const int n = d >> 6, r = d & 63, wc = r >> 4, fq = (r >> 2) & 3, j = r & 3; return 32 * wc + 16 * n + 4 * fq + j; }
__host__ __device__ __forceinline__ int s_of_d(int d) { return c8_of_ph(ph_of_d(d)); }
__host__ __device__ __forceinline__ int d_of_s(int s) { return d_of_ph(ph_of_c8(s)); }
__host__ __device__ __forceinline__ int win_col(int np) {
    const int tile = np >> 8, bj = (np >> 7) & 1, ph = np & 127;
    if (tile < 8)  return (2 * tile + bj) * 128 + d_of_ph(ph);
    if (tile < 10) return 2048 + (2 * (tile - 8) + bj) * 128 + d_of_ph(ph);
    if (tile < 12) return 2560 + (tile - 10) * 256 + bj * 128 + c8_of_ph(ph);
    if (tile < 16) return 3072 + (tile - 12) * 256 + bj * 128 + c8_of_ph(ph);
    if (tile < 24) return (bj ? 5120 : 4096) + (tile - 16) * 128 + c8_of_ph(ph);
    return (bj ? 8192 : 6144) + (tile - 24) * 128 + c8_of_ph(ph);
}
__device__ __forceinline__ int mod_index(int m) { return m < NCTX ? 0 : 1 + ((m - NCTX) >> 11); }

__device__ __forceinline__ void ph_ada_partials(const Params& p, LAS float* st, int gw, int ngw, int lane, int tid, int nthr) {
    for (int i = tid; i < NMOD * DM; i += nthr) { const int ci = i / DM, d = i % DM; const float v = ci == 0 ? p.c_ctx[d] : p.c[(ci - 1) * DM + d]; st[d * 12 + ci] = v / (1.f + expf(-v)); }
    __syncthreads();
    float* PART = (float*)(p.ws + WS_PART);
    for (int it = gw; it < DEPTH * 48 * 8; it += ngw) {
        const int ks = it & 7, cb = (it >> 3) % 48, l = it / (8 * 48);
        const float* w = p.w_ada + ((size_t)l * DM + ks * 256) * ADA_N + cb * 256 + lane * 4;
        f32x4 acc[NMOD];
#pragma unroll
        for (int ci = 0; ci < NMOD; ++ci) acc[ci] = (f32x4){0.f, 0.f, 0.f, 0.f};
#pragma unroll 4
        for (int d = 0; d < 256; ++d) {
            const f32x4 wv = *(const f32x4*)(w + (size_t)d * ADA_N); const LAS float* s = st + (ks * 256 + d) * 12;
            const f32x4 s0 = *(const LAS f32x4*)s, s1 = *(const LAS f32x4*)(s + 4); const float s8 = s[8];
            acc[0] += s0[0] * wv; acc[1] += s0[1] * wv; acc[2] += s0[2] * wv; acc[3] += s0[3] * wv;
            acc[4] += s1[0] * wv; acc[5] += s1[1] * wv; acc[6] += s1[2] * wv; acc[7] += s1[3] * wv; acc[8] += s8 * wv;
        }
#pragma unroll
        for (int ci = 0; ci < NMOD; ++ci) *(f32x4*)(PART + ((size_t)((ks * DEPTH + l) * NMOD + ci)) * ADA_N + cb * 256 + lane * 4) = acc[ci];
    }
}
__device__ __forceinline__ void ph_ada_reduce(const Params& p, int gt, int ngt) {
    const float* PART = (const float*)(p.ws + WS_PART); float* MODS = (float*)(p.ws + WS_MODS);
    for (int i = gt; i < DEPTH * NMOD * (ADA_N / 4); i += ngt) {
        const int e4 = i % (ADA_N / 4), ci = (i / (ADA_N / 4)) % NMOD, l = i / ((ADA_N / 4) * NMOD);
        f32x4 s = *(const f32x4*)(p.b_ada + (size_t)l * ADA_N + e4 * 4);
#pragma unroll
        for (int ks = 0; ks < 8; ++ks) s += *(const f32x4*)(PART + ((size_t)((ks * DEPTH + l) * NMOD + ci)) * ADA_N + e4 * 4);
        *(f32x4*)(MODS + ((size_t)(l * NMOD + ci)) * ADA_N + e4 * 4) = s;
    }
}
__device__ __forceinline__ void ph_misc_prep(const Params& p, int gt, int ngt) {
    float* RC = (float*)(p.ws + WS_ROPE); float* RS = RC + 2048 * 64;
    for (int i = gt; i < 2048 * 64; i += ngt) { const int t = i >> 6, ii = i & 63, f = ii & 31; const float inv = powf(10000.0f, -(float)f / 32.0f);
        const float ang = (ii < 32 ? (float)(t >> 6) : (float)(t & 63)) * inv; float sn, cs; sincosf(ang, &sn, &cs); RC[i] = cs; RS[i] = sn; }
    bf16* KC = (bf16*)(p.ws + WS_KC); bf16* VC = (bf16*)(p.ws + WS_VC);
    for (int i = gt; i < DEPTH * 8 * 256 * 64; i += ngt) {
        const int g8 = i & 15, kvh = (i >> 4) & 3, t = (i >> 6) & 255, b = (i >> 14) & 7, l = i >> 17;
        const size_t src = ((((size_t)b * DEPTH + l) * 256 + t) * NKV + kvh) * HD, dst = (((size_t)l * 8 + b) * 256 + t) * DKV + kvh * HD + g8 * 8;
        { const f32x4 a = *(const f32x4*)(p.cache_v + src + g8 * 8), c = *(const f32x4*)(p.cache_v + src + g8 * 8 + 4);
          *(v4u*)(VC + dst) = (v4u){pk2(a[0], a[1]), pk2(a[2], a[3]), pk2(c[0], c[1]), pk2(c[2], c[3])}; }
        { const int d0 = d_of_s(g8 * 8);
          const f32x4 a = *(const f32x4*)(p.cache_k + src + d0), c = *(const f32x4*)(p.cache_k + src + d0 + 64);
          *(v4u*)(KC + dst) = (v4u){pk2(a[0], a[1]), pk2(a[2], a[3]), pk2(c[0], c[1]), pk2(c[2], c[3])}; }
    }
}
__device__ __forceinline__ void wt_item(const float* W0, const float* W1, int K, int Nsrc, int Nphys, int kind, bf16* WT, LAS float* scr, int item, int lane) {
    const int nblk = Nphys / 32, kb = item / nblk, nb = item % nblk, k0 = 64 * kb, n0 = 32 * nb;
    const int np = n0 + (lane & 31); const float* W = W0; int col;
    if (kind == 0) col = np;
    else if (kind == 1) col = (np & ~127) | c8_of_ph(np & 127);
    else if (kind == 2) col = win_col(np);
    else { col = (np >> 8) * 128 + c8_of_ph(np & 127); if ((np >> 7) & 1) W = W1; }
#pragma unroll 8
    for (int i = 0; i < 32; ++i) { const int kk = 2 * i + (lane >> 5); scr[kk * 33 + (lane & 31)] = W[(size_t)(k0 + kk) * Nsrc + col]; }
    asm volatile("s_waitcnt lgkmcnt(0)" ::: "memory");
    const int c = lane & 7;
#pragma unroll
    for (int j = 0; j < 4; ++j) { const int n = (lane >> 3) + 8 * j; const LAS float* s = scr + (8 * c) * 33 + n;
        v4u o; o.x = pk2(s[0 * 33], s[1 * 33]); o.y = pk2(s[2 * 33], s[3 * 33]); o.z = pk2(s[4 * 33], s[5 * 33]); o.w = pk2(s[6 * 33], s[7 * 33]);
        *(v4u*)(WT + (size_t)(n0 + n) * K + k0 + 8 * c) = o; }
    asm volatile("s_waitcnt lgkmcnt(0)" ::: "memory");
}
constexpr int WI_IN = (DM / 64) * (NIN / 32), WI_A = (DCONV / 64) * (DM / 32), WI_B = (DM / 64) * (DM / 32), WI_O = WI_B, WI_GU = (DM / 64) * (NGU / 32), WI_D = (DFF / 64) * (DM / 32);
constexpr int WI_LAYER = WI_IN + WI_A + WI_B + WI_O + WI_GU + WI_D;
__device__ __forceinline__ void ph_weights(const Params& p, LAS float* scr  , int gw, int ngw, int lane) {
    for (int it = gw; it < DEPTH * WI_LAYER; it += ngw) {
        const int l = it / WI_LAYER; int r = it % WI_LAYER; unsigned char* wl = p.ws + WS_W + (size_t)l * W_LAYER;
        if (r < WI_IN) { wt_item(p.w_in + (size_t)l * DM * NIN, nullptr, DM, NIN, NIN, 2, (bf16*)(wl + W_IN), scr, r, lane); continue; } r -= WI_IN;
        if (r < WI_A)  { wt_item(p.w_a + (size_t)l * DCONV * DM, nullptr, DCONV, DM, DM, 1, (bf16*)(wl + W_A), scr, r, lane); continue; } r -= WI_A;
        if (r < WI_B)  { wt_item(p.w_b + (size_t)l * DM * DM, nullptr, DM, DM, DM, 1, (bf16*)(wl + W_B), scr, r, lane); continue; } r -= WI_B;
        if (r < WI_O)  { wt_item(p.w_o + (size_t)l * DM * DM, nullptr, DM, DM, DM, 0, (bf16*)(wl + W_O), scr, r, lane); continue; } r -= WI_O;
        if (r < WI_GU) { wt_item(p.w_gate + (size_t)l * DM * DFF, p.w_up + (size_t)l * DM * DFF, DM, DFF, NGU, 3, (bf16*)(wl + W_GU), scr, r, lane); continue; } r -= WI_GU;
        wt_item(p.w_down + (size_t)l * DFF * DM, nullptr, DFF, DM, DM, 0, (bf16*)(wl + W_D), scr, r, lane);
    }
}
__device__ __forceinline__ const float* x_in_row(const Params& p, int m) { return m < NCTX ? p.x_prompt + (size_t)m * DM : p.x_sample + (size_t)(m - NCTX) * DM; }
__device__ __forceinline__ void ph_norm(const Params& p, int layer, int which, int gw, int ngw, int lane) {
    const float* g = (which ? p.norm2 : p.norm1) + (size_t)layer * DM; const float* MODS = (const float*)(p.ws + WS_MODS); bf16* HB = (bf16*)(p.ws + WS_HB);
    for (int m = gw; m < MTOK; m += ngw) {
        const float* xr = (layer == 0 && which == 0) ? x_in_row(p, m) : p.out + (size_t)m * DM;
        const float* mod = MODS + ((size_t)(layer * NMOD + mod_index(m)) * 6 + 3 * which) * DM;
        f32x4 v[8]; float ss = 0.f;
#pragma unroll
        for (int j = 0; j < 8; ++j) { v[j] = *(const f32x4*)(xr + (j * 64 + lane) * 4); ss += (v[j][0] * v[j][0] + v[j][1] * v[j][1]) + (v[j][2] * v[j][2] + v[j][3] * v[j][3]); }
        const float rstd = 1.0f / sqrtf(wave_sum(ss) * (1.0f / DM) + EPS);
#pragma unroll
        for (int j = 0; j < 8; ++j) { const int c = (j * 64 + lane) * 4; const f32x4 gv = *(const f32x4*)(g + c), sh = *(const f32x4*)(mod + c), sc = *(const f32x4*)(mod + DM + c);
            const f32x4 y = (v[j] * rstd) * gv * (sc + 1.0f) + sh;
            *(v2u*)(HB + (size_t)m * DM + c) = (v2u){pk2(y[0], y[1]), pk2(y[2], y[3])}; }
    }
}
__device__ __forceinline__ void ph_conv(const Params& p, int layer, int gt, int ngt) {
    bf16* CVB = (bf16*)(p.ws + WS_CVB); const bf16* U = (const bf16*)(p.ws + WS_U);
    const float* cw = p.conv_w + (size_t)layer * 3 * DCONV; const float* cb = p.conv_b + (size_t)layer * DCONV;
    for (int i = gt; i < MTOK * (DCONV / 8); i += ngt) {
        const int m = i >> 7, ch0 = (i & 127) * 8; int t, S; if (m < NCTX) { t = m & 255; S = 256; } else { t = (m - NCTX) & 2047; S = 2048; }
        const v4u z = (v4u){0u, 0u, 0u, 0u};
        const v4u b8 = *(const v4u*)(CVB + (size_t)m * DCONV + ch0), u0 = *(const v4u*)(U + (size_t)m * DCONV + ch0);
        const v4u um = t > 0 ? *(const v4u*)(U + (size_t)(m - 1) * DCONV + ch0) : z, up = t < S - 1 ? *(const v4u*)(U + (size_t)(m + 1) * DCONV + ch0) : z;
        float y[8];
#pragma unroll
        for (int k = 0; k < 8; ++k) { const int w = k >> 1; const bool hi = k & 1;
            const float bv = hi ? bfhi(b8[w]) : bflo(b8[w]), a0 = hi ? bfhi(u0[w]) : bflo(u0[w]), am = hi ? bfhi(um[w]) : bflo(um[w]), ap = hi ? bfhi(up[w]) : bflo(up[w]);
            y[k] = bv * (cw[ch0 + k] * am + cw[DCONV + ch0 + k] * a0 + cw[2 * DCONV + ch0 + k] * ap + cb[ch0 + k]); }
        *(v4u*)(CVB + (size_t)m * DCONV + ch0) = (v4u){pk2(y[0], y[1]), pk2(y[2], y[3]), pk2(y[4], y[5]), pk2(y[6], y[7])};
    }
}
__device__ __forceinline__ void ph_final_norm(const Params& p, int gw, int ngw, int lane) {
    for (int m = gw; m < MTOK; m += ngw) {
        float* xr = p.out + (size_t)m * DM; f32x4 v[8]; float ss = 0.f;
#pragma unroll
        for (int j = 0; j < 8; ++j) { v[j] = *(const f32x4*)(xr + (j * 64 + lane) * 4); ss += (v[j][0] * v[j][0] + v[j][1] * v[j][1]) + (v[j][2] * v[j][2] + v[j][3] * v[j][3]); }
        const float rstd = 1.0f / sqrtf(wave_sum(ss) * (1.0f / DM) + EPS);
#pragma unroll
        for (int j = 0; j < 8; ++j) { const int c = (j * 64 + lane) * 4; *(f32x4*)(xr + c) = (v[j] * rstd) * *(const f32x4*)(p.norm_f + c); }
    }
}
__global__ void __launch_bounds__(512, 2) ok_gemm(const bf16* A, const bf16* Bt, float* C, int M, int N, int K) {
    extern __shared__ __attribute__((aligned(16))) unsigned char lds[];
    pg8::Gemm g{A, Bt, M, N, K}; pg8::StaticOrder S; S.init(M, N, (int)gridDim.x, (int)blockIdx.x);
    pg8::EpiF32 E{C, N};
    pg8::gemm_phase<pg8::EpiF32, pg8::StaticOrder, true, true>((LAS unsigned char*)lds, g, S, E);
}
__global__ void __launch_bounds__(512) ok_prep_a(Params p) {
    extern __shared__ __attribute__((aligned(16))) unsigned char lds[];
    const int tid = threadIdx.x, lane = tid & 63, wave = tid >> 6;
    ph_ada_partials(p, (LAS float*)lds, blockIdx.x * 8 + wave, gridDim.x * 8, lane, tid, 512);
    ph_misc_prep(p, blockIdx.x * 512 + tid, gridDim.x * 512);
}
__global__ void __launch_bounds__(512) ok_prep_w(Params p) {
    extern __shared__ __attribute__((aligned(16))) unsigned char lds[];
    const int tid = threadIdx.x, lane = tid & 63, wave = tid >> 6;
    ph_weights(p, (LAS float*)lds + wave * (64 * 33), blockIdx.x * 8 + wave, gridDim.x * 8, lane);
}
__global__ void __launch_bounds__(512) ok_ada_reduce(Params p) { ph_ada_reduce(p, blockIdx.x * 512 + threadIdx.x, gridDim.x * 512); }
__global__ void __launch_bounds__(512) ok_norm(Params p, int layer, int which) { ph_norm(p, layer, which, blockIdx.x * 8 + (threadIdx.x >> 6), gridDim.x * 8, threadIdx.x & 63); }
__global__ void __launch_bounds__(512) ok_conv(Params p, int layer) { ph_conv(p, layer, blockIdx.x * 512 + threadIdx.x, gridDim.x * 512); }
__global__ void __launch_bounds__(512) ok_final(Params p) { ph_final_norm(p, blockIdx.x * 8 + (threadIdx.x >> 6), gridDim.x * 8, threadIdx.x & 63); }

__global__ void __launch_bounds__(256) ok_epi_in(Params p, int layer, int row0, int nrows) {
    const float* C = (const float*)(p.ws + WS_C); const int lane = threadIdx.x & 63, gw = blockIdx.x * 4 + (threadIdx.x >> 6), ngw = gridDim.x * 4;
    bf16* QB = (bf16*)(p.ws + WS_Q); bf16* KB = (bf16*)(p.ws + WS_K); bf16* VB = (bf16*)(p.ws + WS_V); bf16* CVB = (bf16*)(p.ws + WS_CVB); bf16* U = (bf16*)(p.ws + WS_U);
    bf16* SA = (bf16*)(p.ws + WS_SA); bf16* SB = (bf16*)(p.ws + WS_SB);
    const float* RC = (const float*)(p.ws + WS_ROPE); const float* RS = RC + 2048 * 64;
    for (int it = gw; it < nrows * 20; it += ngw) {
        const int r = it / 20, hh = it % 20, m = row0 + r; const bool isk = hh >= 16; const int h = isk ? hh - 16 : hh;
        const float* crow = C + (size_t)r * NIN + (isk ? 2048 : 0) + (h >> 1) * 256 + (h & 1) * 128;
        const float x1 = crow[ph_of_d(lane)], x2 = crow[ph_of_d(lane + 64)];
        const float rstd = 1.0f / sqrtf(wave_sum(x1 * x1 + x2 * x2) * (1.0f / HD) + EPS);
        const float* gain = (isk ? p.k_gain : p.q_gain) + (size_t)layer * HD;
        float y1 = x1 * rstd * gain[lane], y2 = x2 * rstd * gain[lane + 64];
        if (m >= NCTX) { const int t = (m - NCTX) & 2047; const float cs = RC[t * 64 + lane], sn = RS[t * 64 + lane]; const float a = y1 * cs - y2 * sn, b = y2 * cs + y1 * sn; y1 = a; y2 = b; }
        bf16* dst = isk ? KB + (size_t)m * DKV + h * HD : QB + (size_t)m * DM + h * HD;
        dst[s_of_d(lane)] = (bf16)f2bf(y1); dst[s_of_d(lane + 64)] = (bf16)f2bf(y2);
        if (isk && m < NCTX) { float* nk = p.out + OUT_NK + ((size_t)((m >> 8) * DEPTH + layer) * 256 + (m & 255)) * DKV + h * HD; nk[lane] = y1; nk[lane + 64] = y2; }
    }
    const int gt = blockIdx.x * 256 + threadIdx.x, ngt = gridDim.x * 256;
    for (int i = gt; i < nrows * 512; i += ngt) {
        const int r = i >> 9, col = i & 511, m = row0 + r; const float v = C[(size_t)r * NIN + 2560 + (col & ~127) + ph_of_c8(col & 127)];
        VB[(size_t)m * DKV + col] = (bf16)f2bf(v);
        if (m < NCTX) p.out[OUT_NV + ((size_t)((m >> 8) * DEPTH + layer) * 256 + (m & 255)) * DKV + col] = v;
    }
    for (int i = gt; i < nrows * 1024; i += ngt) {
        const int r = i >> 10, ch = i & 1023, m = row0 + r; const float* cr = C + (size_t)r * NIN;
        CVB[(size_t)m * DCONV + ch] = (bf16)f2bf(cr[3072 + (ch & ~127) + ph_of_c8(ch & 127)]);
        const float* t = cr + 4096 + (ch >> 7) * 256 + ph_of_c8(ch & 127); U[(size_t)m * DCONV + ch] = (bf16)f2bf(t[0] * t[128]);
    }
    for (int i = gt; i < nrows * 2048; i += ngt) {
        const int r = i >> 11, ch = i & 2047, m = row0 + r; const float* t = C + (size_t)r * NIN + 6144 + (ch >> 7) * 256 + ph_of_c8(ch & 127);
        SA[(size_t)m * DM + ch] = (bf16)f2bf(sigmoidf_(t[0])); SB[(size_t)m * DM + ch] = (bf16)f2bf(sigmoidf_(t[128]));
    }
}
__global__ void __launch_bounds__(256) ok_epi_misc(Params p, int layer, int row0, int nrows, int mode) {
    const float* C = (const float*)(p.ws + WS_C); const int gt = blockIdx.x * 256 + threadIdx.x, ngt = gridDim.x * 256;
    const float* MODS = (const float*)(p.ws + WS_MODS);
    if (mode == 4) {
        bf16* ACT = (bf16*)(p.ws + WS_ACT);
        for (int i = gt; i < nrows * DFF; i += ngt) { const int r = i / DFF, ch = i % DFF; const float* t = C + (size_t)r * NGU + (ch >> 7) * 256 + ph_of_c8(ch & 127);
            const float g = t[0], u = t[128]; ACT[(size_t)(row0 + r) * DFF + ch] = (bf16)f2bf(g / (1.f + __expf(-g)) * u); }
        return;
    }
    float* TMP = (float*)(p.ws + WS_TMP); bf16* HB = (bf16*)(p.ws + WS_HB); const bf16* SA = (const bf16*)(p.ws + WS_SA); const bf16* SB = (const bf16*)(p.ws + WS_SB);
    for (int i = gt; i < nrows * DM; i += ngt) {
        const int r = i >> 11, col = i & 2047, m = row0 + r; const size_t o = (size_t)m * DM + col;
        if (mode == 0) TMP[o] = bf2f(SA[o]) * C[(size_t)r * DM + (col & ~127) + ph_of_c8(col & 127)];
        else if (mode == 1) HB[o] = (bf16)f2bf(TMP[o] + bf2f(SB[o]) * C[(size_t)r * DM + (col & ~127) + ph_of_c8(col & 127)]);
        else { const float gt_ = MODS[((size_t)(layer * NMOD + mod_index(m)) * 6 + (mode == 2 ? 2 : 5)) * DM + col];
               const float xo = (layer == 0 && mode == 2) ? x_in_row(p, m)[col] : p.out[o]; p.out[o] = xo + gt_ * C[(size_t)r * DM + col]; }
    }
}
__global__ void __launch_bounds__(64) ok_attn(Params p, int layer) {
    const int lane = threadIdx.x; int u = blockIdx.x; int m, head, n0, n1 = 0; const bf16 *K0, *V0, *K1 = nullptr, *V1 = nullptr;
    const bf16* KB = (const bf16*)(p.ws + WS_K); const bf16* VB = (const bf16*)(p.ws + WS_V);
    if (u < 2048) { const int b = u >> 6; head = (u >> 2) & 15; m = b * 256 + (u & 3) * 64 + lane; K0 = KB + (size_t)(b * 256) * DKV; V0 = VB + (size_t)(b * 256) * DKV; n0 = 256; }
    else { u -= 2048; const int b = u >> 9; head = (u >> 5) & 15; m = NCTX + b * 2048 + (u & 31) * 64 + lane; K0 = KB + (size_t)(NCTX + b * 2048) * DKV; V0 = VB + (size_t)(NCTX + b * 2048) * DKV; n0 = 2048;
           K1 = (const bf16*)(p.ws + WS_KC) + (size_t)((layer * 8 + b) * 256) * DKV; V1 = (const bf16*)(p.ws + WS_VC) + (size_t)((layer * 8 + b) * 256) * DKV; n1 = 256; }
    const int kvh = head >> 2; bf16* QO = (bf16*)(p.ws + WS_Q) + (size_t)m * DM + head * HD;
    float q[HD], o[HD];
#pragma unroll
    for (int c = 0; c < 16; ++c) { const v4u w = *(const v4u*)(QO + c * 8);
#pragma unroll
        for (int e = 0; e < 4; ++e) { q[c * 8 + 2 * e] = bflo(w[e]) * 0.08838834764831845f; q[c * 8 + 2 * e + 1] = bfhi(w[e]) * 0.08838834764831845f; } }
#pragma unroll
    for (int d = 0; d < HD; ++d) o[d] = 0.f;
    float mx = -1e30f, l = 0.f;
    for (int seg = 0; seg < 2; ++seg) {
        const bf16* Ks = seg ? K1 : K0; const bf16* Vs = seg ? V1 : V0; const int n = seg ? n1 : n0;
        for (int k0 = 0; k0 < n; k0 += 4) {
            float s[4];
#pragma unroll
            for (int kk = 0; kk < 4; ++kk) { const bf16* kr = Ks + (size_t)(k0 + kk) * DKV + kvh * HD; float a = 0.f;
#pragma unroll
                for (int c = 0; c < 16; ++c) { const v4u w = *(const v4u*)(kr + c * 8);
#pragma unroll
                    for (int e = 0; e < 4; ++e) { a += q[c * 8 + 2 * e] * bflo(w[e]); a += q[c * 8 + 2 * e + 1] * bfhi(w[e]); } }
                s[kk] = a; }
            const float mb = fmaxf(fmaxf(s[0], s[1]), fmaxf(s[2], s[3])), mn = fmaxf(mx, mb), alpha = __expf(mx - mn); mx = mn; l *= alpha;
#pragma unroll
            for (int d = 0; d < HD; ++d) o[d] *= alpha;
#pragma unroll
            for (int kk = 0; kk < 4; ++kk) { const float pk = __expf(s[kk] - mn); l += pk; const bf16* vr = Vs + (size_t)(k0 + kk) * DKV + kvh * HD;
#pragma unroll
                for (int c = 0; c < 16; ++c) { const v4u w = *(const v4u*)(vr + c * 8);
#pragma unroll
                    for (int e = 0; e < 4; ++e) { o[c * 8 + 2 * e] += pk * bflo(w[e]); o[c * 8 + 2 * e + 1] += pk * bfhi(w[e]); } } }
        }
    }
    const float il = 1.0f / l;
#pragma unroll
    for (int c = 0; c < 16; ++c) *(v4u*)(QO + c * 8) = (v4u){pk2(o[c * 8] * il, o[c * 8 + 1] * il), pk2(o[c * 8 + 2] * il, o[c * 8 + 3] * il), pk2(o[c * 8 + 4] * il, o[c * 8 + 5] * il), pk2(o[c * 8 + 6] * il, o[c * 8 + 7] * il)};
}
static Params make_params(void* const* d_in, void* d_out, void* d_ws) {
    Params p{};
    p.x_prompt = (const float*)d_in[0]; p.x_sample = (const float*)d_in[1]; p.cache_k = (const float*)d_in[2]; p.cache_v = (const float*)d_in[3];
    p.c = (const float*)d_in[4]; p.c_ctx = (const float*)d_in[5]; p.w_ada = (const float*)d_in[6]; p.b_ada = (const float*)d_in[7]; p.norm1 = (const float*)d_in[8];
    p.w_in = (const float*)d_in[9]; p.q_gain = (const float*)d_in[10]; p.k_gain = (const float*)d_in[11]; p.conv_w = (const float*)d_in[12]; p.conv_b = (const float*)d_in[13];
    p.w_a = (const float*)d_in[14]; p.w_b = (const float*)d_in[15]; p.w_o = (const float*)d_in[16]; p.norm2 = (const float*)d_in[17];
    p.w_gate = (const float*)d_in[18]; p.w_up = (const float*)d_in[19]; p.w_down = (const float*)d_in[20]; p.norm_f = (const float*)d_in[21];
    p.out = (float*)d_out; p.ws = (unsigned char*)d_ws; return p;
}
static void oracle_forward(const Params& p, hipStream_t stream) {
    unsigned char* ws = p.ws; float* C = (float*)(ws + WS_C);
    hipLaunchKernelGGL(ok_prep_a, dim3(256), dim3(512), 98304, stream, p);
    hipLaunchKernelGGL(ok_prep_w, dim3(512), dim3(512), 67584, stream, p);
    hipLaunchKernelGGL(ok_ada_reduce, dim3(216), dim3(512), 0, stream, p);
    constexpr int CH = 4096, NCH = MTOK / CH;
    for (int l = 0; l < DEPTH; ++l) {
        const unsigned char* wl = ws + WS_W + (size_t)l * W_LAYER;
        hipLaunchKernelGGL(ok_norm, dim3(1024), dim3(512), 0, stream, p, l, 0);
        for (int c = 0; c < NCH; ++c) {
            hipLaunchKernelGGL(ok_gemm, dim3(256), dim3(512), 131072, stream, (const bf16*)(ws + WS_HB) + (size_t)c * CH * DM, (const bf16*)(wl + W_IN), C, CH, NIN, DM);
            hipLaunchKernelGGL(ok_epi_in, dim3(2048), dim3(256), 0, stream, p, l, c * CH, CH);
        }
        hipLaunchKernelGGL(ok_conv, dim3(1024), dim3(512), 0, stream, p, l);
        hipLaunchKernelGGL(ok_attn, dim3(2048 + 4096), dim3(64), 0, stream, p, l);
        for (int c = 0; c < NCH; ++c) {
            hipLaunchKernelGGL(ok_gemm, dim3(256), dim3(512), 131072, stream, (const bf16*)(ws + WS_CVB) + (size_t)c * CH * DCONV, (const bf16*)(wl + W_A), C, CH, DM, DCONV);
            hipLaunchKernelGGL(ok_epi_misc, dim3(2048), dim3(256), 0, stream, p, l, c * CH, CH, 0);
        }
        for (int c = 0; c < NCH; ++c) {
            hipLaunchKernelGGL(ok_gemm, dim3(256), dim3(512), 131072, stream, (const bf16*)(ws + WS_Q) + (size_t)c * CH * DM, (const bf16*)(wl + W_B), C, CH, DM, DM);
            hipLaunchKernelGGL(ok_epi_misc, dim3(2048), dim3(256), 0, stream, p, l, c * CH, CH, 1);
        }
        for (int c = 0; c < NCH; ++c) {
            hipLaunchKernelGGL(ok_gemm, dim3(256), dim3(512), 131072, stream, (const bf16*)(ws + WS_HB) + (size_t)c * CH * DM, (const bf16*)(wl + W_O), C, CH, DM, DM);
            hipLaunchKernelGGL(ok_epi_misc, dim3(2048), dim3(256), 0, stream, p, l, c * CH, CH, 2);
        }
        hipLaunchKernelGGL(ok_norm, dim3(1024), dim3(512), 0, stream, p, l, 1);
        for (int c = 0; c < NCH; ++c) {
            hipLaunchKernelGGL(ok_gemm, dim3(256), dim3(512), 131072, stream, (const bf16*)(ws + WS_HB) + (size_t)c * CH * DM, (const bf16*)(wl + W_GU), C, CH, NGU, DM);
            hipLaunchKernelGGL(ok_epi_misc, dim3(2048), dim3(256), 0, stream, p, l, c * CH, CH, 4);
        }
        for (int c = 0; c < NCH; ++c) {
            hipLaunchKernelGGL(ok_gemm, dim3(256), dim3(512), 131072, stream, (const bf16*)(ws + WS_ACT) + (size_t)c * CH * DFF, (const bf16*)(wl + W_D), C, CH, DM, DFF);
            hipLaunchKernelGGL(ok_epi_misc, dim3(2048), dim3(256), 0, stream, p, l, c * CH, CH, 3);
        }
    }
    hipLaunchKernelGGL(ok_final, dim3(1024), dim3(512), 0, stream, p);
}
extern "C" void kernel_launch(void* const* d_in, const int* in_sizes, int n_in, void* d_out, int out_size, void* d_ws, size_t ws_size, hipStream_t stream) {
    static int ok = 0;
    if (ok == 0) {
        if (n_in != 22 || out_size != 83886080 || ws_size < WS_END) { fprintf(stderr, "kernel_launch: unexpected shapes: n_in %d out %d ws %zu (need %zu)\n", n_in, out_size, ws_size, (size_t)WS_END); ok = -1; return; }
        (void)hipFuncSetAttribute((const void*)ok_gemm, hipFuncAttributeMaxDynamicSharedMemorySize, 131072);
        (void)hipFuncSetAttribute((const void*)ok_prep_a, hipFuncAttributeMaxDynamicSharedMemorySize, 98304);
        (void)hipFuncSetAttribute((const void*)ok_prep_w, hipFuncAttributeMaxDynamicSharedMemorySize, 67584);
        ok = 1;
    }
    if (ok < 0) return;
    const Params p = make_params(d_in, d_out, d_ws);
    oracle_forward(p, stream);
}
```

```cpp
#include <hip/hip_runtime.h>
#include <cstdio>
#include <cstdint>
namespace pg8 {
#define PG8_LAS __attribute__((address_space(3)))
typedef unsigned short bf16_t;
typedef short bf16x8 __attribute__((ext_vector_type(8)));
typedef float f32x4 __attribute__((ext_vector_type(4)));
typedef unsigned u32x4 __attribute__((ext_vector_type(4)));
constexpr int BM = 256, BK = 64, HALF = 128, HTB = HALF * BK * 2  , STAGE_BYTES = 8 * HTB, NXCD = 8, WGM = 8;

__host__ __device__ __forceinline__ int lds_byte(int r, int c) { const int st = (r >> 4) * 2 + (c >> 5), rr = r & 15, cc = c & 31, ob = rr * 64 + cc * 2; return st * 1024 + (ob ^ (((ob >> 9) & 1) << 5)); }
__host__ __device__ __forceinline__ void stage_rc(int b, int& R, int& C) { const int st = b / 1024, sb = b % 1024, swz = sb ^ (((sb >> 9) & 1) << 5); R = (st >> 1) * 16 + swz / 64; C = (st & 1) * 32 + (swz % 64) / 2; }
__host__ __device__ __forceinline__ int perm32(int rho) { const int n = rho >> 4, i = rho & 15; return 8 * (i >> 2) + 4 * n + (i & 3); }

struct Unit { int pm, pn; };
struct Gemm { const bf16_t* A; const bf16_t* Bt; int M, N, K; };

struct StaticOrder {
    int nM, nN, nwg, G, c;
    __host__ __device__ void init(int M, int N, int G_, int c_) { nM = M / BM; nN = N / BM; nwg = nM * nN; G = G_; c = c_; }
    __host__ __device__ bool next(int i, Unit& u) const {
        const long L = (long)i * G + c; if (L >= nwg) return false;
        int wgid = (int)L; { const int q = nwg / NXCD, r = nwg % NXCD, xcd = wgid % NXCD, off = wgid / NXCD; wgid = (xcd < r ? xcd * (q + 1) : r * (q + 1) + (xcd - r) * q) + off; }
        const int nig = WGM * nN, gid = wgid / nig, fm = gid * WGM, gsz = (nM - fm) < WGM ? (nM - fm) : WGM;
        u.pm = fm + ((wgid % nig) % gsz); u.pn = (wgid % nig) / gsz; return true;
    }
    __device__ __forceinline__ void a_ready(const Unit&) const {}
    __device__ __forceinline__ void done(const Unit&) const {}
};

__device__ __forceinline__ unsigned cvt_pk_bf16(float lo, float hi) { unsigned r; asm volatile("v_cvt_pk_bf16_f32 %0, %1, %2" : "=v"(r) : "v"(lo), "v"(hi)); return r; }
template <class Epi, class Sched, bool ALIGN_EPI = false, bool SP2 = false, int WRSEL = 0>
__device__ __forceinline__ void gemm_phase(PG8_LAS unsigned char* lds, const Gemm g, const Sched& S, const Epi& E) {
    int tid = threadIdx.x; asm volatile("" : "+v"(tid));
    const int wid = __builtin_amdgcn_readfirstlane(tid >> 6), lane = tid & 63, wc = wid & 3, fr = lane & 15, fq = lane >> 4; constexpr int wr = WRSEL;
    int K = g.K; asm volatile("" : "+s"(K));     const int nt = K / BK;
    unsigned voffA[2], voffB[2];
#pragma unroll
    for (int i = 0; i < 2; ++i) { int R, C; stage_rc(tid * 16 + i * 8192, R, C); const int Rb = Epi::PERM ? ((R & ~31) + perm32(R & 31)) : R;
        voffA[i] = (unsigned)(R * K + C) * 2u; voffB[i] = (unsigned)(Rb * K + C) * 2u; }
    const size_t kstep = (size_t)(BK * 2);
    const size_t hstep = (size_t)HALF * K * 2;
    const size_t tstep = 2 * hstep;
    const unsigned ldsw = (unsigned)wid * 1024u;
    const int aoff = lds_byte(wr * 64 + fr, fq * 8), boff = lds_byte(wc * 32 + fr, fq * 8);
#define PG8_SA(b, h) (((b) * 2 + (h)) * HTB)
#define PG8_SB(b, h) ((4 + (b) * 2 + (h)) * HTB)
#define PG8_STAGE(bufoff, gbase, voff) do { const char* gb_ = (const char*)(gbase); asm volatile("" : "+s"(gb_));     \
        _Pragma("unroll") for (int _i = 0; _i < 2; ++_i) \
        __builtin_amdgcn_global_load_lds((const unsigned*)(gb_ + (voff)[_i]), (PG8_LAS unsigned*)(lds + (bufoff) + ldsw + _i * 8192), 16, 0, 0); } while (0)
#define PG8_LDA(dst, b, h) do { _Pragma("unroll") for (int m = 0; m < 4; ++m) _Pragma("unroll") for (int k = 0; k < 2; ++k) dst[m][k] = *(const PG8_LAS bf16x8*)(lds + PG8_SA(b, h) + aoff + m * 2048 + k * 1024); } while (0)
#define PG8_LDB(dst, b, h) do { _Pragma("unroll") for (int n = 0; n < 2; ++n) _Pragma("unroll") for (int k = 0; k < 2; ++k) dst[n][k] = *(const PG8_LAS bf16x8*)(lds + PG8_SB(b, h) + boff + n * 2048 + k * 1024); } while (0)
#define PG8_MMA(ai, bj, At, Bt) do { __builtin_amdgcn_s_setprio(1); _Pragma("unroll") for (int m = 0; m < 4; ++m) _Pragma("unroll") for (int n = 0; n < 2; ++n) _Pragma("unroll") for (int k = 0; k < 2; ++k) \
        acc[ai][bj][m][n] = __builtin_amdgcn_mfma_f32_16x16x32_bf16(Bt[n][k], At[m][k], acc[ai][bj][m][n], 0, 0, 0); __builtin_amdgcn_s_setprio(0); } while (0)
#define PG8_MMA0(ai, bj, At, Bt) do { if (zc) { __builtin_amdgcn_s_setprio(1); const f32x4 z4_ = (f32x4){0.f, 0.f, 0.f, 0.f}; _Pragma("unroll") for (int m = 0; m < 4; ++m) _Pragma("unroll") for (int n = 0; n < 2; ++n) { \
        acc[ai][bj][m][n] = __builtin_amdgcn_mfma_f32_16x16x32_bf16(Bt[n][0], At[m][0], z4_, 0, 0, 0); acc[ai][bj][m][n] = __builtin_amdgcn_mfma_f32_16x16x32_bf16(Bt[n][1], At[m][1], acc[ai][bj][m][n], 0, 0, 0); } \
        __builtin_amdgcn_s_setprio(0); } else PG8_MMA(ai, bj, At, Bt); } while (0)
#define PG8_WAIT_V(n) asm volatile("s_waitcnt vmcnt(" #n ")" ::: "memory")
#define PG8_WAIT_L(n) asm volatile("s_waitcnt lgkmcnt(" #n ")" ::: "memory")
#define PG8_BAR __builtin_amdgcn_s_barrier()
#define PG8_SCHED __builtin_amdgcn_sched_barrier(0)
    Unit cur, nxt; int ui = 0;
    if (!S.next(0, cur)) return;
    f32x4 acc[2][2][4][2];
    bf16x8 At[4][2], B0[2][2], B1[2][2];
    const char* cA = (const char*)g.A + (size_t)cur.pm * tstep; const char* cB = (const char*)g.Bt + (size_t)cur.pn * tstep;
    S.a_ready(cur);
    if constexpr (SP2) {
        PG8_STAGE(PG8_SB(0, 0), cB, voffB); PG8_STAGE(PG8_SB(0, 1), cB + hstep, voffB); PG8_STAGE(PG8_SA(0, 0), cA, voffA); PG8_STAGE(PG8_SA(0, 1), cA + hstep, voffA);
        if (wr == 1) PG8_BAR;
        PG8_WAIT_V(2); PG8_BAR;
        PG8_STAGE(PG8_SB(1, 0), cB + kstep, voffB); PG8_STAGE(PG8_SB(1, 1), cB + hstep + kstep, voffB);
        PG8_WAIT_V(6); PG8_BAR;
    } else {
        PG8_STAGE(PG8_SB(0, 0), cB, voffB); PG8_STAGE(PG8_SA(0, 0), cA, voffA); PG8_STAGE(PG8_SB(0, 1), cB + hstep, voffB); PG8_STAGE(PG8_SA(0, 1), cA + hstep, voffA);
        if (wr == 1) PG8_BAR;
        PG8_WAIT_V(4); PG8_BAR;
        PG8_STAGE(PG8_SB(1, 0), cB + kstep, voffB); PG8_STAGE(PG8_SA(1, 0), cA + kstep, voffA); PG8_STAGE(PG8_SB(1, 1), cB + hstep + kstep, voffB);
        PG8_WAIT_V(6); PG8_BAR;
    }
    for (;;) {
        const bool has_next = S.next(ui + 1, nxt);
        const char* nA = has_next ? (const char*)g.A + (size_t)nxt.pm * tstep : cA; const char* nB = has_next ? (const char*)g.Bt + (size_t)nxt.pn * tstep : cB;
        for (int t = 0; t < nt; t += 2) {
            const bool last = (t == nt - 2); const bool zc = (t == 0);
            asm volatile("" : "+v"(voffA[0]), "+v"(voffA[1]), "+v"(voffB[0]), "+v"(voffB[1]));
            const char* a1 = cA + (size_t)(t + 1) * kstep;
            const char* a2 = last ? nA : cA + (size_t)(t + 2) * kstep; const char* b2 = last ? nB : cB + (size_t)(t + 2) * kstep;
            const char* a3 = a2 + kstep; const char* b3 = b2 + kstep;
            if (last && has_next) S.a_ready(nxt);
            if constexpr (SP2) {
            PG8_LDB(B0, 0, 0); PG8_LDB(B1, 0, 1); PG8_SCHED; PG8_LDA(At, 0, 0); PG8_STAGE(PG8_SA(1, 0), a1, voffA); PG8_STAGE(PG8_SA(1, 1), a1 + hstep, voffA);
            PG8_WAIT_V(8); PG8_WAIT_L(0); PG8_BAR; PG8_MMA0(0, 0, At, B0); PG8_MMA0(0, 1, At, B1); PG8_BAR; PG8_SCHED;
            PG8_LDA(At, 0, 1); PG8_STAGE(PG8_SB(0, 0), b2, voffB); PG8_STAGE(PG8_SB(0, 1), b2 + hstep, voffB);
            PG8_WAIT_V(6); PG8_WAIT_L(0); PG8_BAR; PG8_MMA0(1, 0, At, B0); PG8_MMA0(1, 1, At, B1); PG8_BAR; PG8_SCHED;
            PG8_LDB(B0, 1, 0); PG8_LDB(B1, 1, 1); PG8_SCHED; PG8_LDA(At, 1, 0); PG8_STAGE(PG8_SA(0, 0), a2, voffA); PG8_STAGE(PG8_SA(0, 1), a2 + hstep, voffA);
            PG8_WAIT_V(8); PG8_WAIT_L(0); PG8_BAR; PG8_MMA(0, 0, At, B0); PG8_MMA(0, 1, At, B1); PG8_BAR; PG8_SCHED;
            PG8_LDA(At, 1, 1); PG8_STAGE(PG8_SB(1, 0), b3, voffB); PG8_STAGE(PG8_SB(1, 1), b3 + hstep, voffB);
            PG8_WAIT_V(6); PG8_WAIT_L(0); PG8_BAR; PG8_MMA(1, 0, At, B0); PG8_MMA(1, 1, At, B1); PG8_BAR; PG8_SCHED;
            } else {
            PG8_LDB(B0, 0, 0); PG8_SCHED; PG8_LDA(At, 0, 0); PG8_STAGE(PG8_SA(1, 1), a1 + hstep, voffA);
            PG8_WAIT_L(8); PG8_BAR; PG8_WAIT_L(0); PG8_MMA(0, 0, At, B0); PG8_BAR; PG8_SCHED;
            PG8_LDB(B1, 0, 1); PG8_STAGE(PG8_SB(0, 0), b2, voffB);
            PG8_BAR; PG8_WAIT_L(0); PG8_MMA(0, 1, At, B1); PG8_BAR;
            PG8_LDA(At, 0, 1); PG8_STAGE(PG8_SA(0, 0), a2, voffA);
            PG8_BAR; PG8_WAIT_L(0); PG8_MMA(1, 0, At, B0); PG8_BAR; PG8_SCHED;
            PG8_STAGE(PG8_SB(0, 1), b2 + hstep, voffB);
            PG8_WAIT_V(6); PG8_BAR; PG8_MMA(1, 1, At, B1); PG8_BAR;
            PG8_LDB(B0, 1, 0); PG8_SCHED; PG8_LDA(At, 1, 0); PG8_STAGE(PG8_SA(0, 1), a2 + hstep, voffA);
            PG8_WAIT_L(8); PG8_BAR; PG8_WAIT_L(0); PG8_MMA(0, 0, At, B0); PG8_BAR; PG8_SCHED;
            PG8_LDB(B1, 1, 1); PG8_STAGE(PG8_SB(1, 0), b3, voffB);
            PG8_BAR; PG8_WAIT_L(0); PG8_MMA(0, 1, At, B1); PG8_BAR;
            PG8_LDA(At, 1, 1); PG8_STAGE(PG8_SA(1, 0), a3, voffA);
            PG8_BAR; PG8_WAIT_L(0); PG8_MMA(1, 0, At, B0); PG8_BAR; PG8_SCHED;
            PG8_STAGE(PG8_SB(1, 1), b3 + hstep, voffB);
            PG8_WAIT_V(6); PG8_BAR; PG8_MMA(1, 1, At, B1); PG8_BAR;
            }
        }
        if constexpr (ALIGN_EPI) { if (wr == 0) PG8_BAR; }
        if constexpr (!Epi::AFTER_DRAIN) { E(acc, cur, wr, wc, fr, fq); S.done(cur); }
        if (!has_next) break;
        cur = nxt; cA = nA; cB = nB; ++ui;
        if constexpr (ALIGN_EPI) { if (wr == 1) PG8_BAR; }
    }
    PG8_WAIT_V(0);
    if constexpr (!ALIGN_EPI) { if (wr == 0) PG8_BAR; }
    PG8_BAR;
    if constexpr (Epi::AFTER_DRAIN) { E.fused(acc, cur, wr, wc, fr, fq, lds, wid, lane); S.done(cur); }
#undef PG8_SA
#undef PG8_SB
#undef PG8_STAGE
#undef PG8_LDA
#undef PG8_LDB
#undef PG8_MMA
#undef PG8_MMA0
#undef PG8_WAIT_V
#undef PG8_WAIT_L
#undef PG8_BAR
#undef PG8_SCHED
}
struct Gemm2 { const bf16_t *A1, *B1, *A2, *B2; int nt1, nt2, K; };
template <class Mid, class Epi, class Sched, bool ALIGN_EPI = false, bool SP2 = false, int WRSEL = 0>
__device__ __forceinline__ void gemm_phase_ab(PG8_LAS unsigned char* lds, const Gemm2 g, const Sched& S, const Mid& Mm, const Epi& E) {
    int tid = threadIdx.x; asm volatile("" : "+v"(tid));
    const int wid = __builtin_amdgcn_readfirstlane(tid >> 6), lane = tid & 63, wc = wid & 3, fr = lane & 15, fq = lane >> 4; constexpr int wr = WRSEL;
    int K = g.K; asm volatile("" : "+s"(K));     int nt = g.nt1; int seg = 0;
    unsigned voffA[2], voffB[2];
#pragma unroll
    for (int i = 0; i < 2; ++i) { int R, C; stage_rc(tid * 16 + i * 8192, R, C); const int Rb = Epi::PERM ? ((R & ~31) + perm32(R & 31)) : R;
        voffA[i] = (unsigned)(R * K + C) * 2u; voffB[i] = (unsigned)(Rb * K + C) * 2u; }
    const size_t kstep = (size_t)(BK * 2);
    const size_t hstep = (size_t)HALF * K * 2;
    const size_t tstep = 2 * hstep;
    const unsigned ldsw = (unsigned)wid * 1024u;
    const int aoff = lds_byte(wr * 64 + fr, fq * 8), boff = lds_byte(wc * 32 + fr, fq * 8);
#define PG8_SA(b, h) (((b) * 2 + (h)) * HTB)
#define PG8_SB(b, h) ((4 + (b) * 2 + (h)) * HTB)
#define PG8_STAGE(bufoff, gbase, voff) do { const char* gb_ = (const char*)(gbase); asm volatile("" : "+s"(gb_));     \
        _Pragma("unroll") for (int _i = 0; _i < 2; ++_i) \
        __builtin_amdgcn_global_load_lds((const unsigned*)(gb_ + (voff)[_i]), (PG8_LAS unsigned*)(lds + (bufoff) + ldsw + _i * 8192), 16, 0, 0); } while (0)
#define PG8_LDA(dst, b, h) do { _Pragma("unroll") for (int m = 0; m < 4; ++m) _Pragma("unroll") for (int k = 0; k < 2; ++k) dst[m][k] = *(const PG8_LAS bf16x8*)(lds + PG8_SA(b, h) + aoff + m * 2048 + k * 1024); } while (0)
#define PG8_LDB(dst, b, h) do { _Pragma("unroll") for (int n = 0; n < 2; ++n) _Pragma("unroll") for (int k = 0; k < 2; ++k) dst[n][k] = *(const PG8_LAS bf16x8*)(lds + PG8_SB(b, h) + boff + n * 2048 + k * 1024); } while (0)
#define PG8_MMA(ai, bj, At, Bt) do { __builtin_amdgcn_s_setprio(1); _Pragma("unroll") for (int m = 0; m < 4; ++m) _Pragma("unroll") for (int n = 0; n < 2; ++n) _Pragma("unroll") for (int k = 0; k < 2; ++k) \
        acc[ai][bj][m][n] = __builtin_amdgcn_mfma_f32_16x16x32_bf16(Bt[n][k], At[m][k], acc[ai][bj][m][n], 0, 0, 0); __builtin_amdgcn_s_setprio(0); } while (0)
#define PG8_MMA0(ai, bj, At, Bt) do { if (zc) { __builtin_amdgcn_s_setprio(1); const f32x4 z4_ = (f32x4){0.f, 0.f, 0.f, 0.f}; _Pragma("unroll") for (int m = 0; m < 4; ++m) _Pragma("unroll") for (int n = 0; n < 2; ++n) { \
        acc[ai][bj][m][n] = __builtin_amdgcn_mfma_f32_16x16x32_bf16(Bt[n][0], At[m][0], z4_, 0, 0, 0); acc[ai][bj][m][n] = __builtin_amdgcn_mfma_f32_16x16x32_bf16(Bt[n][1], At[m][1], acc[ai][bj][m][n], 0, 0, 0); } \
        __builtin_amdgcn_s_setprio(0); } else PG8_MMA(ai, bj, At, Bt); } while (0)
#define PG8_WAIT_V(n) asm volatile("s_waitcnt vmcnt(" #n ")" ::: "memory")
#define PG8_WAIT_L(n) asm volatile("s_waitcnt lgkmcnt(" #n ")" ::: "memory")
#define PG8_BAR __builtin_amdgcn_s_barrier()
#define PG8_SCHED __builtin_amdgcn_sched_barrier(0)
    Unit cur, nxt; int ui = 0;
    if (!S.next(0, cur)) return;
    f32x4 acc[2][2][4][2];
    bf16x8 At[4][2], B0[2][2], B1[2][2];
    const char* cA = (const char*)g.A1 + (size_t)cur.pm * tstep; const char* cB = (const char*)g.B1 + (size_t)cur.pn * tstep;
    S.a_ready(cur);
    if constexpr (SP2) {
        PG8_STAGE(PG8_SB(0, 0), cB, voffB); PG8_STAGE(PG8_SB(0, 1), cB + hstep, voffB); PG8_STAGE(PG8_SA(0, 0), cA, voffA); PG8_STAGE(PG8_SA(0, 1), cA + hstep, voffA);
        if (wr == 1) PG8_BAR;
        PG8_WAIT_V(2); PG8_BAR;
        PG8_STAGE(PG8_SB(1, 0), cB + kstep, voffB); PG8_STAGE(PG8_SB(1, 1), cB + hstep + kstep, voffB);
        PG8_WAIT_V(6); PG8_BAR;
    } else {
        PG8_STAGE(PG8_SB(0, 0), cB, voffB); PG8_STAGE(PG8_SA(0, 0), cA, voffA); PG8_STAGE(PG8_SB(0, 1), cB + hstep, voffB); PG8_STAGE(PG8_SA(0, 1), cA + hstep, voffA);
        if (wr == 1) PG8_BAR;
        PG8_WAIT_V(4); PG8_BAR;
        PG8_STAGE(PG8_SB(1, 0), cB + kstep, voffB); PG8_STAGE(PG8_SA(1, 0), cA + kstep, voffA); PG8_STAGE(PG8_SB(1, 1), cB + hstep + kstep, voffB);
        PG8_WAIT_V(6); PG8_BAR;
    }
    for (;;) {
        bool has_next; const char* nA; const char* nB; int nnt;
        if (seg == 0) { has_next = true; nA = (const char*)g.A2 + (size_t)cur.pm * tstep; nB = (const char*)g.B2 + (size_t)cur.pn * tstep; nnt = g.nt2; }
        else { has_next = S.next(ui + 1, nxt); nA = has_next ? (const char*)g.A1 + (size_t)nxt.pm * tstep : cA; nB = has_next ? (const char*)g.B1 + (size_t)nxt.pn * tstep : cB; nnt = g.nt1; }
        for (int t = 0; t < nt; t += 2) {
            const bool last = (t == nt - 2); const bool zc = (t == 0) && (seg == 0);
            asm volatile("" : "+v"(voffA[0]), "+v"(voffA[1]), "+v"(voffB[0]), "+v"(voffB[1]));
            const char* a1 = cA + (size_t)(t + 1) * kstep;
            const char* a2 = last ? nA : cA + (size_t)(t + 2) * kstep; const char* b2 = last ? nB : cB + (size_t)(t + 2) * kstep;
            const char* a3 = a2 + kstep; const char* b3 = b2 + kstep;
            if (last && has_next) S.a_ready(nxt);
            if constexpr (SP2) {
            PG8_LDB(B0, 0, 0); PG8_LDB(B1, 0, 1); PG8_SCHED; PG8_LDA(At, 0, 0); PG8_STAGE(PG8_SA(1, 0), a1, voffA); PG8_STAGE(PG8_SA(1, 1), a1 + hstep, voffA);
            PG8_WAIT_V(8); PG8_WAIT_L(0); PG8_BAR; PG8_MMA0(0, 0, At, B0); PG8_MMA0(0, 1, At, B1); PG8_BAR; PG8_SCHED;
            PG8_LDA(At, 0, 1); PG8_STAGE(PG8_SB(0, 0), b2, voffB); PG8_STAGE(PG8_SB(0, 1), b2 + hstep, voffB);
            PG8_WAIT_V(6); PG8_WAIT_L(0); PG8_BAR; PG8_MMA0(1, 0, At, B0); PG8_MMA0(1, 1, At, B1); PG8_BAR; PG8_SCHED;
            PG8_LDB(B0, 1, 0); PG8_LDB(B1, 1, 1); PG8_SCHED; PG8_LDA(At, 1, 0); PG8_STAGE(PG8_SA(0, 0), a2, voffA); PG8_STAGE(PG8_SA(0, 1), a2 + hstep, voffA);
            PG8_WAIT_V(8); PG8_WAIT_L(0); PG8_BAR; PG8_MMA(0, 0, At, B0); PG8_MMA(0, 1, At, B1); PG8_BAR; PG8_SCHED;
            PG8_LDA(At, 1, 1); PG8_STAGE(PG8_SB(1, 0), b3, voffB); PG8_STAGE(PG8_SB(1, 1), b3 + hstep, voffB);
            PG8_WAIT_V(6); PG8_WAIT_L(0); PG8_BAR; PG8_MMA(1, 0, At, B0); PG8_MMA(1, 1, At, B1); PG8_BAR; PG8_SCHED;
            } else {
            PG8_LDB(B0, 0, 0); PG8_SCHED; PG8_LDA(At, 0, 0); PG8_STAGE(PG8_SA(1, 1), a1 + hstep, voffA);
            PG8_WAIT_L(8); PG8_BAR; PG8_WAIT_L(0); PG8_MMA(0, 0, At, B0); PG8_BAR; PG8_SCHED;
            PG8_LDB(B1, 0, 1); PG8_STAGE(PG8_SB(0, 0), b2, voffB);
            PG8_BAR; PG8_WAIT_L(0); PG8_MMA(0, 1, At, B1); PG8_BAR;
            PG8_LDA(At, 0, 1); PG8_STAGE(PG8_SA(0, 0), a2, voffA);
            PG8_BAR; PG8_WAIT_L(0); PG8_MMA(1, 0, At, B0); PG8_BAR; PG8_SCHED;
            PG8_STAGE(PG8_SB(0, 1), b2 + hstep, voffB);
            PG8_WAIT_V(6); PG8_BAR; PG8_MMA(1, 1, At, B1); PG8_BAR;
            PG8_LDB(B0, 1, 0); PG8_SCHED; PG8_LDA(At, 1, 0); PG8_STAGE(PG8_SA(0, 1), a2 + hstep, voffA);
            PG8_WAIT_L(8); PG8_BAR; PG8_WAIT_L(0); PG8_MMA(0, 0, At, B0); PG8_BAR; PG8_SCHED;
            PG8_LDB(B1, 1, 1); PG8_STAGE(PG8_SB(1, 0), b3, voffB);
            PG8_BAR; PG8_WAIT_L(0); PG8_MMA(0, 1, At, B1); PG8_BAR;
            PG8_LDA(At, 1, 1); PG8_STAGE(PG8_SA(1, 0), a3, voffA);
            PG8_BAR; PG8_WAIT_L(0); PG8_MMA(1, 0, At, B0); PG8_BAR; PG8_SCHED;
            PG8_STAGE(PG8_SB(1, 1), b3 + hstep, voffB);
            PG8_WAIT_V(6); PG8_BAR; PG8_MMA(1, 1, At, B1); PG8_BAR;
            }
        }
        if constexpr (ALIGN_EPI) { if (wr == 0) PG8_BAR; }
        if (seg == 0) Mm(acc, cur, wr, wc, fr, fq); else { E(acc, cur, wr, wc, fr, fq); S.done(cur); }
        if (!has_next) break;
        if (seg == 1) { cur = nxt; ++ui; }
        cA = nA; cB = nB; nt = nnt; seg ^= 1;
        if constexpr (ALIGN_EPI) { if (wr == 1) PG8_BAR; }
    }
    PG8_WAIT_V(0);
    if constexpr (!ALIGN_EPI) { if (wr == 0) PG8_BAR; }
    PG8_BAR;
#undef PG8_SA
#undef PG8_SB
#undef PG8_STAGE
#undef PG8_LDA
#undef PG8_LDB
#undef PG8_MMA
#undef PG8_MMA0
#undef PG8_WAIT_V
#undef PG8_WAIT_L
#undef PG8_BAR
#undef PG8_SCHED
}
}
#define GAS __attribute__((address_space(1)))
#define LAS __attribute__((address_space(3)))
typedef unsigned short bf16;
typedef unsigned v4u __attribute__((ext_vector_type(4)));
typedef unsigned v2u __attribute__((ext_vector_type(2)));
typedef float f32x4 __attribute__((ext_vector_type(4)));
typedef short bf16x8 __attribute__((ext_vector_type(8)));

constexpr int DM = 2048, NCTX = 8192, NLAT = 16384, MTOK = 24576, DEPTH = 4;
constexpr int NH = 16, NKV = 4, HD = 128, DKV = 512, DCONV = 1024, DFF = 5632;
constexpr int NIN = 10240, NGU = 11264, NMOD = 9, ADA_N = 12288;
constexpr float EPS = 1e-6f;

constexpr size_t MiB = 1u << 20;
constexpr size_t WS_CTL = 0, CTL_ZERO_BYTES = 32768;
constexpr size_t WS_MODS = 1 * MiB;
constexpr size_t WS_ROPE = 3 * MiB;
constexpr size_t WS_PART = 4 * MiB;
constexpr size_t WS_KC = 18 * MiB, WS_VC = 26 * MiB;
constexpr size_t WS_W = 34 * MiB;
constexpr size_t W_LAYER = 130 * MiB, W_IN = 0, W_A = 40 * MiB, W_B = 48 * MiB, W_O = 56 * MiB, W_GU = 64 * MiB, W_D = 108 * MiB;
constexpr size_t WS_HB = 554 * MiB;
constexpr size_t WS_Q = 650 * MiB;
constexpr size_t WS_K = 746 * MiB, WS_V = 770 * MiB;
constexpr size_t WS_CVB = 794 * MiB;
constexpr size_t WS_U = 890 * MiB;
constexpr size_t WS_R = 938 * MiB, WS_SB = 1034 * MiB;
constexpr size_t WS_ACT = 1130 * MiB;
constexpr size_t WS_X = 1394 * MiB;
constexpr size_t WS_END = 1490 * MiB;
constexpr int LDCV = 2048;
constexpr size_t OUT_YS = (size_t)NCTX * DM, OUT_NK = (size_t)MTOK * DM, OUT_NV = OUT_NK + (size_t)32 * 4 * 256 * 512;

struct Params {
    const float *x_prompt, *x_sample, *cache_k, *cache_v, *c, *c_ctx, *w_ada, *b_ada, *norm1, *w_in, *q_gain, *k_gain, *conv_w, *conv_b,
                *w_a, *w_b, *w_o, *norm2, *w_gate, *w_up, *w_down, *norm_f;
    float* out; unsigned char* ws;
};

__device__ __forceinline__ unsigned f2bf(float f) { unsigned u = __builtin_bit_cast(unsigned, f); return (u + 0x7fffu + ((u >> 16) & 1u)) >> 16; }
__device__ __forceinline__ unsigned pk2(float lo, float hi) { return f2bf(lo) | (f2bf(hi) << 16); }
__device__ __forceinline__ float bf2f(unsigned b) { return __builtin_bit_cast(float, b << 16); }
__device__ __forceinline__ float bflo(unsigned w) { return __builtin_bit_cast(float, w << 16); }
__device__ __forceinline__ float bfhi(unsigned w) { return __builtin_bit_cast(float, w & 0xffff0000u); }
__device__ __forceinline__ float wave_sum(float v) {
#define SWZ_XOR(k) v += __builtin_bit_cast(float, __builtin_amdgcn_ds_swizzle(__builtin_bit_cast(int, v), 0x1F | ((k) << 10)))
    SWZ_XOR(1); SWZ_XOR(2); SWZ_XOR(4); SWZ_XOR(8); SWZ_XOR(16);
#undef SWZ_XOR
    return __builtin_bit_cast(float, __builtin_amdgcn_readlane(__builtin_bit_cast(int, v), 0)) + __builtin_bit_cast(float, __builtin_amdgcn_readlane(__builtin_bit_cast(int, v), 32));
}
__device__ __forceinline__ float sigmoidf_(float v) { return 1.f / (1.f + __expf(-v)); }

__host__ __device__ __forceinline__ int c8_of_ph(int ph) { const int wc = ph >> 5, n = (ph >> 4) & 1, fq = (ph >> 2) & 3, j = ph & 3; return 32 * wc + 8 * fq + 4 * n + j; }
__host__ __device__ __forceinline__ int ph_of_c8(int c) { const int wc = c >> 5, fq = (c >> 3) & 3, n = (c >> 2) & 1, j = c & 3; return 32 * wc + 16 * n + 4 * fq + j; }
__host__ __device__ __forceinline__ int d_of_ph(int ph) { const int wc = ph >> 5, n = (ph >> 4) & 1, fq = (ph >> 2) & 3, j = ph & 3; return 16 * wc + 4 * fq + j + 64 * n; }
__host__ __device__ __forceinline__ int ph_of_d(int d) { const int n = d >> 6, r = d & 63, wc = r >> 4, fq = (r >> 2) & 3, j = r & 3; return 32 * wc + 16 * n + 4 * fq + j; }
__host__ __device__ __forceinline__ int s_of_d(int d) { return c8_of_ph(ph_of_d(d)); }
__host__ __device__ __forceinline__ int d_of_s(int s) { return d_of_ph(ph_of_c8(s)); }
__host__ __device__ __forceinline__ int win_col(int np) {
    const int tile = np >> 8, bj = (np >> 7) & 1, ph = np & 127;
    if (tile < 8)  return (2 * tile + bj) * 128 + d_of_ph(ph);
    if (tile < 10) return 2048 + (2 * (tile - 8) + bj) * 128 + d_of_ph(ph);
    if (tile < 12) return 2560 + (tile - 10) * 256 + bj * 128 + c8_of_ph(ph);
    if (tile < 16) return 3072 + (tile - 12) * 256 + bj * 128 + c8_of_ph(ph);
    if (tile < 24) return (bj ? 5120 : 4096) + (tile - 16) * 128 + c8_of_ph(ph);
    return (bj ? 8192 : 6144) + (tile - 24) * 128 + c8_of_ph(ph);
}
__device__ __forceinline__ int mod_index(int m) { return m < NCTX ? 0 : 1 + ((m - NCTX) >> 11); }

__device__ __forceinline__ void ph_ada_partials(const Params& p, LAS float* st, int gw, int ngw, int lane, int tid, int nthr) {
    for (int i = tid; i < NMOD * DM; i += nthr) { const int ci = i / DM, d = i % DM; const float v = ci == 0 ? p.c_ctx[d] : p.c[(ci - 1) * DM + d]; st[d * 12 + ci] = v / (1.f + expf(-v)); }
    __syncthreads();
    float* PART = (float*)(p.ws + WS_PART);
    for (int it = gw; it < DEPTH * 48 * 8; it += ngw) {
        const int ks = it & 7, cb = (it >> 3) % 48, l = it / (8 * 48);
        const float* w = p.w_ada + ((size_t)l * DM + ks * 256) * ADA_N + cb * 256 + lane * 4;
        f32x4 acc[NMOD];
#pragma unroll
        for (int ci = 0; ci < NMOD; ++ci) acc[ci] = (f32x4){0.f, 0.f, 0.f, 0.f};
#pragma unroll 8
        for (int d = 0; d < 256; ++d) {
            const f32x4 wv = *(const f32x4*)(w + (size_t)d * ADA_N); const LAS float* s = st + (ks * 256 + d) * 12;
            const f32x4 s0 = *(const LAS f32x4*)s, s1 = *(const LAS f32x4*)(s + 4); const float s8 = s[8];
            acc[0] += s0[0] * wv; acc[1] += s0[1] * wv; acc[2] += s0[2] * wv; acc[3] += s0[3] * wv;
            acc[4] += s1[0] * wv; acc[5] += s1[1] * wv; acc[6] += s1[2] * wv; acc[7] += s1[3] * wv; acc[8] += s8 * wv;
        }
#pragma unroll
        for (int ci = 0; ci < NMOD; ++ci) *(f32x4*)(PART + ((size_t)((ks * DEPTH + l) * NMOD + ci)) * ADA_N + cb * 256 + lane * 4) = acc[ci];
    }
}
__device__ __forceinline__ void ph_ada_reduce(const Params& p, int gt, int ngt) {
    const float* PART = (const float*)(p.ws + WS_PART); float* MODS = (float*)(p.ws + WS_MODS);
    for (int i = gt; i < DEPTH * NMOD * (ADA_N / 4); i += ngt) {
        const int e4 = i % (ADA_N / 4), ci = (i / (ADA_N / 4)) % NMOD, l = i / ((ADA_N / 4) * NMOD);
        f32x4 s = *(const f32x4*)(p.b_ada + (size_t)l * ADA_N + e4 * 4);
#pragma unroll
        for (int ks = 0; ks < 8; ++ks) s += *(const f32x4*)(PART + ((size_t)((ks * DEPTH + l) * NMOD + ci)) * ADA_N + e4 * 4);
        *(f32x4*)(MODS + ((size_t)(l * NMOD + ci)) * ADA_N + e4 * 4) = s;
    }
}
__device__ __forceinline__ const float* x_in_row(const Params& p, int m) { return m < NCTX ? p.x_prompt + (size_t)m * DM : p.x_sample + (size_t)(m - NCTX) * DM; }
__device__ __forceinline__ void ph_misc_prep(const Params& p, int gt, int ngt) {
    float* RC = (float*)(p.ws + WS_ROPE); float* RS = RC + 2048 * 64;
    for (int i = gt; i < 2048 * 64; i += ngt) { const int t = i >> 6, ii = i & 63, f = ii & 31; const float inv = powf(10000.0f, -(float)f / 32.0f);
        const float ang = (ii < 32 ? (float)(t >> 6) : (float)(t & 63)) * inv; float sn, cs; sincosf(ang, &sn, &cs); RC[i] = cs; RS[i] = sn; }
    bf16* KC = (bf16*)(p.ws + WS_KC); bf16* VC = (bf16*)(p.ws + WS_VC);
    for (int i = gt; i < DEPTH * 8 * 256 * 64; i += ngt) {
        const int g8 = i & 15, kvh = (i >> 4) & 3, t = (i >> 6) & 255, b = (i >> 14) & 7, l = i >> 17;
        const size_t src = ((((size_t)b * DEPTH + l) * 256 + t) * NKV + kvh) * HD, dst = (((size_t)l * 8 + b) * 256 + t) * DKV + kvh * HD + g8 * 8;
        { const f32x4 a = *(const f32x4*)(p.cache_v + src + g8 * 8), c = *(const f32x4*)(p.cache_v + src + g8 * 8 + 4);
          *(v4u*)(VC + dst) = (v4u){pk2(a[0], a[1]), pk2(a[2], a[3]), pk2(c[0], c[1]), pk2(c[2], c[3])}; }
        { const int d0 = d_of_s(g8 * 8);
          const f32x4 a = *(const f32x4*)(p.cache_k + src + d0), c = *(const f32x4*)(p.cache_k + src + d0 + 64);
          *(v4u*)(KC + dst) = (v4u){pk2(a[0], a[1]), pk2(a[2], a[3]), pk2(c[0], c[1]), pk2(c[2], c[3])}; }
    }
}
__device__ __forceinline__ void wt_item(const float* W0, const float* W1, int K, int Nsrc, int Nphys, int kind, bf16* WT, int ldo, LAS float* scr, int item, int lane) {
    const int nblk = Nphys / 32, kb = item / nblk, nb = item % nblk, k0 = 64 * kb, n0 = 32 * nb;
    const int np = n0 + (lane & 31); const float* W = W0; int col;
    if (kind == 0) col = np;
    else if (kind == 1) col = (np & ~127) | c8_of_ph(np & 127);
    else if (kind == 2) col = win_col(np);
    else { col = (np >> 8) * 128 + c8_of_ph(np & 127); if ((np >> 7) & 1) W = W1; }
#pragma unroll 8
    for (int i = 0; i < 32; ++i) { const int kk = 2 * i + (lane >> 5); scr[kk * 33 + (lane & 31)] = W[(size_t)(k0 + kk) * Nsrc + col]; }
    asm volatile("s_waitcnt lgkmcnt(0)" ::: "memory");
    const int c = lane & 7;
#pragma unroll
    for (int j = 0; j < 4; ++j) { const int n = (lane >> 3) + 8 * j; const LAS float* s = scr + (8 * c) * 33 + n;
        v4u o; o.x = pk2(s[0 * 33], s[1 * 33]); o.y = pk2(s[2 * 33], s[3 * 33]); o.z = pk2(s[4 * 33], s[5 * 33]); o.w = pk2(s[6 * 33], s[7 * 33]);
        *(v4u*)(WT + (size_t)(n0 + n) * ldo + k0 + 8 * c) = o; }
    asm volatile("s_waitcnt lgkmcnt(0)" ::: "memory");
}
constexpr int WI_IN = (DM / 64) * (NIN / 32), WI_A = (DCONV / 64) * (DM / 32), WI_B = (DM / 64) * (DM / 32), WI_O = WI_B, WI_GU = (DM / 64) * (NGU / 32), WI_D = (DFF / 64) * (DM / 32);
constexpr int WI_LAYER = WI_IN + WI_A + WI_B + WI_O + WI_GU + WI_D;
constexpr int WI_TAIL = 4096;
__device__ __forceinline__ void wt_dispatch(const Params& p, LAS float* scr, int l, int r, int lane) {
    unsigned char* wl = p.ws + WS_W + (size_t)l * W_LAYER;
    if (r < WI_IN) { wt_item(p.w_in + (size_t)l * DM * NIN, nullptr, DM, NIN, NIN, 2, (bf16*)(wl + W_IN), DM, scr, r, lane); return; } r -= WI_IN;
    if (r < WI_A)  { wt_item(p.w_a + (size_t)l * DCONV * DM, nullptr, DCONV, DM, DM, 1, (bf16*)(wl + W_A), DM  , scr, r, lane); return; } r -= WI_A;
    if (r < WI_B)  { wt_item(p.w_b + (size_t)l * DM * DM, nullptr, DM, DM, DM, 1, (bf16*)(wl + W_B), DM, scr, r, lane); return; } r -= WI_B;
    if (r < WI_O)  { wt_item(p.w_o + (size_t)l * DM * DM, nullptr, DM, DM, DM, 1, (bf16*)(wl + W_O), DM, scr, r, lane); return; } r -= WI_O;
    if (r < WI_GU) { wt_item(p.w_gate + (size_t)l * DM * DFF, p.w_up + (size_t)l * DM * DFF, DM, DFF, NGU, 3, (bf16*)(wl + W_GU), DM, scr, r, lane); return; } r -= WI_GU;
    wt_item(p.w_down + (size_t)l * DFF * DM, nullptr, DFF, DM, DM, 1, (bf16*)(wl + W_D), DFF, scr, r, lane);
}
__device__ __forceinline__ void ph_weights(const Params& p, LAS float* scr  , int gw, int ngw, int lane) {
    constexpr int PER = WI_LAYER - WI_TAIL, TOT = WI_LAYER + (DEPTH - 1) * PER;
    for (int it = gw; it < TOT; it += ngw) {
        int l = 0, r = it; if (it >= WI_LAYER) { l = 1 + (it - WI_LAYER) / PER; r = (it - WI_LAYER) % PER; }
        wt_dispatch(p, scr, l, r, lane);
    }
}
__device__ __forceinline__ void ph_weights_tail(const Params& p, LAS float* scr, int l, int tw, int ntw, int lane) {
    for (int it = WI_LAYER - WI_TAIL + tw; it < WI_LAYER; it += ntw) wt_dispatch(p, scr, l, it, lane);
}
__device__ __forceinline__ void norm_load_row(const Params& p, bool from_in, int m, int lane, f32x4 (&v)[8]) {
    if (from_in) { const float* xr = x_in_row(p, m);
#pragma unroll
        for (int j = 0; j < 8; ++j) v[j] = *(const f32x4*)(xr + ((j >> 1) * 64 + lane) * 8 + (j & 1) * 4); }
    else { const bf16* xr = (const bf16*)(p.ws + WS_X) + (size_t)m * DM;
#pragma unroll
        for (int jj = 0; jj < 4; ++jj) { const v4u w = *(const v4u*)(xr + (jj * 64 + lane) * 8);
            v[2 * jj] = (f32x4){bflo(w[0]), bfhi(w[0]), bflo(w[1]), bfhi(w[1])}; v[2 * jj + 1] = (f32x4){bflo(w[2]), bfhi(w[2]), bflo(w[3]), bfhi(w[3])}; } }
}
__device__ __forceinline__ void ph_norm(const Params& p, int layer, int which, int gw, int ngw, int lane) {
    const float* g = (which ? p.norm2 : p.norm1) + (size_t)layer * DM; const float* MODS = (const float*)(p.ws + WS_MODS); bf16* HB = (bf16*)(p.ws + WS_HB);
    constexpr int rpw = MTOK / 2048; const int m0 = gw * rpw; (void)ngw; const bool from_in = (layer == 0 && which == 0);
    f32x4 gs[8], sh[8], v[8], vn[8]; int ci_cur = -1;
    norm_load_row(p, from_in, m0, lane, v);
    for (int r = 0; r < rpw; ++r) {
        const int m = m0 + r, ci = mod_index(m);
        if (ci != ci_cur) { ci_cur = ci; const float* mod = MODS + ((size_t)(layer * NMOD + ci) * 6 + 3 * which) * DM;
#pragma unroll
            for (int j = 0; j < 8; ++j) { const int c = ((j >> 1) * 64 + lane) * 8 + (j & 1) * 4; sh[j] = *(const f32x4*)(mod + c); gs[j] = *(const f32x4*)(g + c) * (*(const f32x4*)(mod + DM + c) + 1.0f); } }
        if (r + 1 < rpw) norm_load_row(p, from_in, m + 1, lane, vn);
        float ss = 0.f;
#pragma unroll
        for (int j = 0; j < 8; ++j) ss += (v[j][0] * v[j][0] + v[j][1] * v[j][1]) + (v[j][2] * v[j][2] + v[j][3] * v[j][3]);
        const float rstd = 1.0f / sqrtf(wave_sum(ss) * (1.0f / DM) + EPS);
#pragma unroll
        for (int jj = 0; jj < 4; ++jj) { const f32x4 y0 = (v[2 * jj] * rstd) * gs[2 * jj] + sh[2 * jj], y1 = (v[2 * jj + 1] * rstd) * gs[2 * jj + 1] + sh[2 * jj + 1];
            *(v4u*)(HB + (size_t)m * DM + (jj * 64 + lane) * 8) = (v4u){pk2(y0[0], y0[1]), pk2(y0[2], y0[3]), pk2(y1[0], y1[1]), pk2(y1[2], y1[3])}; }
#pragma unroll
        for (int j = 0; j < 8; ++j) v[j] = vn[j];
    }
}
__device__ __forceinline__ void ph_conv(const Params& p, int layer, int gt, int ngt) {
    bf16* CVB = (bf16*)(p.ws + WS_CVB); const bf16* U = (const bf16*)(p.ws + WS_U);
    const int ch0 = (gt & 127) * 8; const float* cw = p.conv_w + (size_t)layer * 3 * DCONV + ch0; const float* cb = p.conv_b + (size_t)layer * DCONV + ch0;
    float w0[8], w1[8], w2[8], wb[8];
#pragma unroll
    for (int k = 0; k < 8; ++k) { w0[k] = cw[k]; w1[k] = cw[DCONV + k]; w2[k] = cw[2 * DCONV + k]; wb[k] = cb[k]; }
    for (int i = gt; i < MTOK * (DCONV / 8); i += ngt) {
        const int m = i >> 7; int t, S; if (m < NCTX) { t = m & 255; S = 256; } else { t = (m - NCTX) & 2047; S = 2048; }
        const v4u z = (v4u){0u, 0u, 0u, 0u};
        const v4u b8 = *(const v4u*)(CVB + (size_t)m * LDCV + ch0), u0 = *(const v4u*)(U + (size_t)m * DCONV + ch0);
        const v4u um = t > 0 ? *(const v4u*)(U + (size_t)(m - 1) * DCONV + ch0) : z, up = t < S - 1 ? *(const v4u*)(U + (size_t)(m + 1) * DCONV + ch0) : z;
        float y[8];
#pragma unroll
        for (int k = 0; k < 8; ++k) { const int w = k >> 1; const bool hi = k & 1;
            const float bv = hi ? bfhi(b8[w]) : bflo(b8[w]), a0 = hi ? bfhi(u0[w]) : bflo(u0[w]), am = hi ? bfhi(um[w]) : bflo(um[w]), ap = hi ? bfhi(up[w]) : bflo(up[w]);
            y[k] = bv * (w0[k] * am + w1[k] * a0 + w2[k] * ap + wb[k]); }
        *(v4u*)(CVB + (size_t)m * LDCV + ch0) = (v4u){pk2(y[0], y[1]), pk2(y[2], y[3]), pk2(y[4], y[5]), pk2(y[6], y[7])};
    }
}
__device__ __forceinline__ void ph_final_norm(const Params& p, int gw, int ngw, int lane) {
    constexpr int rpw = MTOK / 2048; const int m0 = gw * rpw; (void)ngw; f32x4 gf[8], v[8], vn[8];
#pragma unroll
    for (int j = 0; j < 8; ++j) gf[j] = *(const f32x4*)(p.norm_f + ((j >> 1) * 64 + lane) * 8 + (j & 1) * 4);
    norm_load_row(p, false, m0, lane, v);
    for (int r = 0; r < rpw; ++r) {
        float* yr = p.out + (size_t)(m0 + r) * DM;
        if (r + 1 < rpw) norm_load_row(p, false, m0 + r + 1, lane, vn);
        float ss = 0.f;
#pragma unroll
        for (int j = 0; j < 8; ++j) ss += (v[j][0] * v[j][0] + v[j][1] * v[j][1]) + (v[j][2] * v[j][2] + v[j][3] * v[j][3]);
        const float rstd = 1.0f / sqrtf(wave_sum(ss) * (1.0f / DM) + EPS);
#pragma unroll
        for (int j = 0; j < 8; ++j) *(f32x4*)(yr + ((j >> 1) * 64 + lane) * 8 + (j & 1) * 4) = (v[j] * rstd) * gf[j];
#pragma unroll
        for (int j = 0; j < 8; ++j) v[j] = vn[j];
    }
}
namespace pg8 {
typedef unsigned u32x4e __attribute__((ext_vector_type(4)));
__device__ __forceinline__ u32x4e pack8(const f32x4 a, const f32x4 b) { u32x4e w; w.x = cvt_pk_bf16(a[0], a[1]); w.y = cvt_pk_bf16(a[2], a[3]); w.z = cvt_pk_bf16(b[0], b[1]); w.w = cvt_pk_bf16(b[2], b[3]); return w; }
__device__ __forceinline__ f32x4 unpack_lo(const u32x4e w) { return (f32x4){__builtin_bit_cast(float, w.x << 16), __builtin_bit_cast(float, w.x & 0xffff0000u), __builtin_bit_cast(float, w.y << 16), __builtin_bit_cast(float, w.y & 0xffff0000u)}; }
__device__ __forceinline__ f32x4 unpack_hi(const u32x4e w) { return (f32x4){__builtin_bit_cast(float, w.z << 16), __builtin_bit_cast(float, w.z & 0xffff0000u), __builtin_bit_cast(float, w.w << 16), __builtin_bit_cast(float, w.w & 0xffff0000u)}; }
__device__ __forceinline__ float fsig(float v) { return __builtin_amdgcn_rcpf(1.0f + __builtin_amdgcn_exp2f(-1.4426950408889634f * v)); }
__device__ __forceinline__ f32x4 fsig4(const f32x4 v) { return (f32x4){fsig(v[0]), fsig(v[1]), fsig(v[2]), fsig(v[3])}; }

struct EpiIn {
    static constexpr bool PERM = false, AFTER_DRAIN = false;
    unsigned char* ws_; float* out_; const float *qg, *kg; PG8_LAS float* P; int layer;
    __device__ __forceinline__ void operator()(const f32x4 (&acc)[2][2][4][2], const Unit& u, int wr, int wc, int fr, int fq) const {
        asm volatile("" : "+v"(fr), "+v"(fq));
        const int pn = u.pn, cq = wc * 32 + fq * 8; const bool lat = u.pm >= 32;
        GAS unsigned char* wsg = (GAS unsigned char*)ws_; GAS float* outg = (GAS float*)out_; asm volatile("" : "+s"(wsg), "+s"(outg));
        unsigned char* ws = (unsigned char*)wsg; float* outp = (float*)outg;
        bf16_t* const QB = (bf16_t*)(ws + WS_Q); bf16_t* const KB = (bf16_t*)(ws + WS_K); bf16_t* const VB = (bf16_t*)(ws + WS_V); bf16_t* const CVB = (bf16_t*)(ws + WS_CVB); bf16_t* const U = (bf16_t*)(ws + WS_U);
        bf16_t* const RR = (bf16_t*)(ws + WS_R); bf16_t* const SB = (bf16_t*)(ws + WS_SB); const float* const RC = (const float*)(ws + WS_ROPE); const float* const RS = RC + 2048 * 64;
        float* const NK = outp + OUT_NK; float* const NV = outp + OUT_NV;
        if (pn < 10) {
            const bool isk = pn >= 8; const float* gain = isk ? kg : qg;
            const f32x4 g0 = *(const f32x4*)(gain + wc * 16 + fq * 4), g1 = *(const f32x4*)(gain + 64 + wc * 16 + fq * 4);
            float sq[16];
#pragma unroll
            for (int i = 0; i < 16; ++i) { const int ai = i >> 3, m = (i >> 1) & 3, bj = i & 1; const f32x4 a = acc[ai][bj][m][0], b = acc[ai][bj][m][1];
                sq[i] = ((a[0] * a[0] + a[1] * a[1]) + (a[2] * a[2] + a[3] * a[3])) + ((b[0] * b[0] + b[1] * b[1]) + (b[2] * b[2] + b[3] * b[3])); }
            { float tq[16]; const int a16 = ((fq ^ 1) * 16 + fr) << 2, a32 = ((fq ^ 2) * 16 + fr) << 2;
#pragma unroll
              for (int i = 0; i < 16; ++i) tq[i] = __builtin_bit_cast(float, __builtin_amdgcn_ds_bpermute(a16, __builtin_bit_cast(int, sq[i])));
#pragma unroll
              for (int i = 0; i < 16; ++i) sq[i] += tq[i];
#pragma unroll
              for (int i = 0; i < 16; ++i) tq[i] = __builtin_bit_cast(float, __builtin_amdgcn_ds_bpermute(a32, __builtin_bit_cast(int, sq[i])));
#pragma unroll
              for (int i = 0; i < 16; ++i) sq[i] += tq[i]; }
            if (fq == 0) {
#pragma unroll
                for (int i = 0; i < 16; ++i) { const int ai = i >> 3, m = (i >> 1) & 3, bj = i & 1; P[((ai * HALF + wr * 64 + m * 16 + fr) * 2 + bj) * 4 + wc] = sq[i]; } }
            asm volatile("s_waitcnt lgkmcnt(0)" ::: "memory"); __builtin_amdgcn_s_barrier(); asm volatile("" ::: "memory");
#pragma unroll
            for (int ai = 0; ai < 2; ++ai) { f32x4 csv[4], snv[4];
#pragma unroll
                for (int m = 0; m < 4; ++m) { csv[m] = (f32x4){1.f, 1.f, 1.f, 1.f}; snv[m] = (f32x4){0.f, 0.f, 0.f, 0.f};
                    if (lat) { const int t = (u.pm * BM + ai * HALF + wr * 64 + m * 16 + fr - 8192) & 2047; csv[m] = *(const f32x4*)(RC + t * 64 + wc * 16 + fq * 4); snv[m] = *(const f32x4*)(RS + t * 64 + wc * 16 + fq * 4); } }
#pragma unroll
                for (int m = 0; m < 4; ++m) { const int r = ai * HALF + wr * 64 + m * 16 + fr, mrow = u.pm * BM + r; const f32x4 cs = csv[m], sn = snv[m];
#pragma unroll
                    for (int bj = 0; bj < 2; ++bj) { const f32x4 pp = *(const PG8_LAS f32x4*)(P + (r * 2 + bj) * 4);
                        const float rstd = 1.0f / sqrtf(((pp[0] + pp[1]) + (pp[2] + pp[3])) * (1.0f / 128.0f) + 1e-6f);
                        f32x4 y1 = acc[ai][bj][m][0] * rstd * g0, y2 = acc[ai][bj][m][1] * rstd * g1;
                        if (lat) { const f32x4 a = y1 * cs - y2 * sn, b = y2 * cs + y1 * sn; y1 = a; y2 = b; }
                        const int head = 2 * (pn - (isk ? 8 : 0)) + bj;
                        bf16_t* dst = isk ? KB + (size_t)mrow * 512 + head * 128 : QB + (size_t)mrow * 2048 + head * 128;
                        *(u32x4e*)(dst + cq) = pack8(y1, y2);
                        if (isk && !lat) { float* nk = NK + ((size_t)((mrow >> 8) * 4 + layer) * 256 + (mrow & 255)) * 512 + head * 128 + wc * 16 + fq * 4; *(f32x4*)nk = y1; *(f32x4*)(nk + 64) = y2; } } } }
        } else if (pn < 16) {
            const bool isv = pn < 12; const int ld = isv ? 512 : LDCV, ct = (isv ? pn - 10 : pn - 12) * 256; bf16_t* base = isv ? VB : CVB;
#pragma unroll
            for (int ai = 0; ai < 2; ++ai)
#pragma unroll
                for (int m = 0; m < 4; ++m) { const int mrow = u.pm * BM + ai * HALF + wr * 64 + m * 16 + fr;
#pragma unroll
                    for (int bj = 0; bj < 2; ++bj) { *(u32x4e*)(base + (size_t)mrow * ld + ct + bj * HALF + cq) = pack8(acc[ai][bj][m][0], acc[ai][bj][m][1]);
                        if (isv && !lat) { float* nv = NV + ((size_t)((mrow >> 8) * 4 + layer) * 256 + (mrow & 255)) * 512 + ct + bj * HALF + cq; *(f32x4*)nv = acc[ai][bj][m][0]; *(f32x4*)(nv + 4) = acc[ai][bj][m][1]; } } }
        } else if (pn < 24) {
#pragma unroll
            for (int ai = 0; ai < 2; ++ai)
#pragma unroll
                for (int m = 0; m < 4; ++m) { const int mrow = u.pm * BM + ai * HALF + wr * 64 + m * 16 + fr;
                    *(u32x4e*)(U + (size_t)mrow * 1024 + (pn - 16) * 128 + cq) = pack8(acc[ai][0][m][0] * acc[ai][1][m][0], acc[ai][0][m][1] * acc[ai][1][m][1]); }
        } else {
#pragma unroll
            for (int ai = 0; ai < 2; ++ai)
#pragma unroll
                for (int m = 0; m < 4; ++m) { const size_t o = (size_t)(u.pm * BM + ai * HALF + wr * 64 + m * 16 + fr) * 2048 + (pn - 24) * 128 + cq;
                    f32x4 rr[2], sb[2];
#pragma unroll
                    for (int n = 0; n < 2; ++n)
#pragma unroll
                        for (int j = 0; j < 4; ++j) { const float da = 1.0f + __builtin_amdgcn_exp2f(-1.4426950408889634f * acc[ai][0][m][n][j]), db = 1.0f + __builtin_amdgcn_exp2f(-1.4426950408889634f * acc[ai][1][m][n][j]);
                            rr[n][j] = db * __builtin_amdgcn_rcpf(da); sb[n][j] = __builtin_amdgcn_rcpf(db); }
                    *(u32x4e*)(RR + o) = pack8(rr[0], rr[1]);
                    *(u32x4e*)(SB + o) = pack8(sb[0], sb[1]); }
        }
    }
};
struct MidR {
    const bf16_t* RR;
    __device__ __forceinline__ void operator()(f32x4 (&acc)[2][2][4][2], const Unit& u, int wr, int wc, int fr, int fq) const {
        asm volatile("" : "+v"(fr), "+v"(fq));
#pragma unroll
        for (int ai = 0; ai < 2; ++ai) { u32x4e s[4][2];
#pragma unroll
            for (int m = 0; m < 4; ++m)
#pragma unroll
                for (int bj = 0; bj < 2; ++bj) s[m][bj] = *(const u32x4e*)(RR + (size_t)(u.pm * BM + ai * HALF + wr * 64 + m * 16 + fr) * 2048 + u.pn * BM + bj * HALF + wc * 32 + fq * 8);
#pragma unroll
            for (int m = 0; m < 4; ++m)
#pragma unroll
                for (int bj = 0; bj < 2; ++bj) { acc[ai][bj][m][0] *= unpack_lo(s[m][bj]); acc[ai][bj][m][1] *= unpack_hi(s[m][bj]); } }
    }
};
struct EpiB2 {
    static constexpr bool PERM = false, AFTER_DRAIN = false;
    const bf16_t* SB; bf16_t* MG;
    __device__ __forceinline__ void operator()(const f32x4 (&acc)[2][2][4][2], const Unit& u, int wr, int wc, int fr, int fq) const {
        asm volatile("" : "+v"(fr), "+v"(fq));
#pragma unroll
        for (int ai = 0; ai < 2; ++ai) { u32x4e s[4][2];
#pragma unroll
            for (int m = 0; m < 4; ++m)
#pragma unroll
                for (int bj = 0; bj < 2; ++bj) s[m][bj] = *(const u32x4e*)(SB + (size_t)(u.pm * BM + ai * HALF + wr * 64 + m * 16 + fr) * 2048 + u.pn * BM + bj * HALF + wc * 32 + fq * 8);
#pragma unroll
            for (int m = 0; m < 4; ++m)
#pragma unroll
                for (int bj = 0; bj < 2; ++bj) *(u32x4e*)(MG + (size_t)(u.pm * BM + ai * HALF + wr * 64 + m * 16 + fr) * 2048 + u.pn * BM + bj * HALF + wc * 32 + fq * 8) = pack8(unpack_lo(s[m][bj]) * acc[ai][bj][m][0], unpack_hi(s[m][bj]) * acc[ai][bj][m][1]); }
    }
};
struct EpiRes {
    static constexpr bool PERM = false, AFTER_DRAIN = false;
    bf16_t* XB; const float* mods; int chunk; const float* xp32; const float* xs32;
    __device__ __forceinline__ void operator()(const f32x4 (&acc)[2][2][4][2], const Unit& u, int wr, int wc, int fr, int fq) const {
        asm volatile("" : "+v"(fr), "+v"(fq));
        const int ci = u.pm < 32 ? 0 : 1 + ((u.pm - 32) >> 3); const float* gt = mods + ((size_t)ci * 6 + chunk) * 2048;
        const int col0 = u.pn * BM + wc * 32 + 8 * fq; f32x4 gv[2][2];
#pragma unroll
        for (int bj = 0; bj < 2; ++bj)
#pragma unroll
            for (int n = 0; n < 2; ++n) gv[bj][n] = *(const f32x4*)(gt + col0 + bj * HALF + n * 4);
        if (xp32) {
            const float* xin = u.pm < 32 ? xp32 + (size_t)(u.pm * BM) * 2048 : xs32 + (size_t)(u.pm * BM - 8192) * 2048;
#pragma unroll
            for (int ai = 0; ai < 2; ++ai)
#pragma unroll
                for (int mh = 0; mh < 2; ++mh) { f32x4 t[2][2][2];
#pragma unroll
                    for (int m2 = 0; m2 < 2; ++m2)
#pragma unroll
                        for (int bj = 0; bj < 2; ++bj)
#pragma unroll
                            for (int n = 0; n < 2; ++n) t[m2][bj][n] = *(const f32x4*)(xin + (size_t)(ai * HALF + wr * 64 + (2 * mh + m2) * 16 + fr) * 2048 + col0 + bj * HALF + n * 4);
#pragma unroll
                    for (int m2 = 0; m2 < 2; ++m2)
#pragma unroll
                        for (int bj = 0; bj < 2; ++bj) *(u32x4e*)(XB + (size_t)(u.pm * BM + ai * HALF + wr * 64 + (2 * mh + m2) * 16 + fr) * 2048 + col0 + bj * HALF) =
                            pack8(t[m2][bj][0] + gv[bj][0] * acc[ai][bj][2 * mh + m2][0], t[m2][bj][1] + gv[bj][1] * acc[ai][bj][2 * mh + m2][1]); }
            return;
        }
        u32x4e s[2][4][2];
#pragma unroll
        for (int ai = 0; ai < 2; ++ai)
#pragma unroll
            for (int m = 0; m < 4; ++m)
#pragma unroll
                for (int bj = 0; bj < 2; ++bj) s[ai][m][bj] = *(const u32x4e*)(XB + (size_t)(u.pm * BM + ai * HALF + wr * 64 + m * 16 + fr) * 2048 + col0 + bj * HALF);
#pragma unroll
        for (int ai = 0; ai < 2; ++ai)
#pragma unroll
            for (int m = 0; m < 4; ++m)
#pragma unroll
                for (int bj = 0; bj < 2; ++bj) *(u32x4e*)(XB + (size_t)(u.pm * BM + ai * HALF + wr * 64 + m * 16 + fr) * 2048 + col0 + bj * HALF) =
                    pack8(unpack_lo(s[ai][m][bj]) + gv[bj][0] * acc[ai][bj][m][0], unpack_hi(s[ai][m][bj]) + gv[bj][1] * acc[ai][bj][m][1]);
    }
};
struct EpiGU {
    static constexpr bool PERM = false, AFTER_DRAIN = false;
    bf16_t* ACT;
    __device__ __forceinline__ void operator()(const f32x4 (&acc)[2][2][4][2], const Unit& u, int wr, int wc, int fr, int fq) const {
        asm volatile("" : "+v"(fr), "+v"(fq));
#pragma unroll
        for (int ai = 0; ai < 2; ++ai)
#pragma unroll
            for (int m = 0; m < 4; ++m) { const f32x4 g0 = acc[ai][0][m][0], g1 = acc[ai][0][m][1];
                *(u32x4e*)(ACT + (size_t)(u.pm * BM + ai * HALF + wr * 64 + m * 16 + fr) * 5632 + u.pn * 128 + wc * 32 + fq * 8) = pack8(g0 * fsig4(g0) * acc[ai][1][m][0], g1 * fsig4(g1) * acc[ai][1][m][1]); }
    }
};
}
namespace att {
using bf16x8 = __attribute__((ext_vector_type(8))) short;
using s16x4  = __attribute__((ext_vector_type(4))) short;
using f32x16 = __attribute__((ext_vector_type(16))) float;
using u32x4  = __attribute__((ext_vector_type(4))) unsigned;
constexpr int   D = 128, NW = 8, QBLK = 32, KVBLK = 64, LDQ = 2048, LDK = 512, LDO = 2048;
constexpr float SCALE = 0.088388347648318440f, THR = 8.f;
constexpr size_t SHM_V = KVBLK * D * 2, SHM_K = KVBLK * D * 2, SHM_ATTN = 2 * SHM_V + 2 * SHM_K + NW * 64 * 4;
#define KSWZ(row, colB) ((row) * 256 + ((colB) ^ (((row) & 7) << 4)))
#define SBAR() __builtin_amdgcn_sched_barrier(0)
__device__ __forceinline__ int crow(int r, int hi) { return (r & 3) + 8 * (r >> 2) + 4 * hi; }
__device__ __forceinline__ unsigned cvtpk(float lo, float hi) { unsigned r; asm volatile("v_cvt_pk_bf16_f32 %0, %1, %2" : "=v"(r) : "v"(lo), "v"(hi)); return r; }
__device__ __forceinline__ void partialSM(f32x16& p0, f32x16& p1, float& m_reg, float& mn, float& alpha) {
  constexpr float C = SCALE * 1.4426950408889634f;
  float pmax = p0[0]; for (int r = 1; r < 16; ++r) pmax = fmaxf(pmax, p0[r]); for (int r = 0; r < 16; ++r) pmax = fmaxf(pmax, p1[r]);
  { auto rr = __builtin_amdgcn_permlane32_swap(__float_as_uint(pmax), __float_as_uint(pmax), false, false);
    pmax = fmaxf(__uint_as_float(rr[0]), __uint_as_float(rr[1])); }
  if (__builtin_expect(__all(pmax - m_reg <= THR / SCALE), 1)) { mn = m_reg; alpha = 1.f; }
  else { mn = fmaxf(m_reg, pmax); alpha = __builtin_amdgcn_exp2f((m_reg - mn) * C); m_reg = mn; }
  float mnC = -mn * C;
  for (int r = 0; r < 16; ++r) p0[r] = fmaf(p0[r], C, mnC); for (int r = 0; r < 16; ++r) p1[r] = fmaf(p1[r], C, mnC);
  for (int r = 0; r < 16; ++r) p0[r] = __builtin_amdgcn_exp2f(p0[r]);
}
__device__ __forceinline__ void finishSM(f32x16& p0, f32x16& p1, float alpha, float& l_reg, bf16x8& pa0, bf16x8& pa1, bf16x8& pa2, bf16x8& pa3) {
  for (int r = 0; r < 16; ++r) p1[r] = __builtin_amdgcn_exp2f(p1[r]);
  float ps = 0; for (int r = 0; r < 16; ++r) ps += p0[r]; for (int r = 0; r < 16; ++r) ps += p1[r];
  { auto rr = __builtin_amdgcn_permlane32_swap(__float_as_uint(ps), __float_as_uint(ps), false, false);
    ps = __uint_as_float(rr[0]) + __uint_as_float(rr[1]); }
  l_reg = l_reg * alpha + ps;
#define PK4(P, BASE, OUT) do { unsigned a0 = cvtpk(P[BASE + 0], P[BASE + 1]), a1 = cvtpk(P[BASE + 2], P[BASE + 3]);   \
    unsigned b0 = cvtpk(P[BASE + 4], P[BASE + 5]), b1 = cvtpk(P[BASE + 6], P[BASE + 7]);                              \
    auto r0 = __builtin_amdgcn_permlane32_swap(a0, b0, false, false); auto r1 = __builtin_amdgcn_permlane32_swap(a1, b1, false, false); \
    u32x4 w = {r0[0], r1[0], r0[1], r1[1]}; OUT = *reinterpret_cast<bf16x8*>(&w); } while (0)
  PK4(p0, 0, pa0); PK4(p0, 8, pa1); PK4(p1, 0, pa2); PK4(p1, 8, pa3);
#undef PK4
}
__device__ __forceinline__ void qkt(f32x16& p0, f32x16& p1, const bf16* Ks, const bf16x8* qr, int r32, int hi) {
  p0 = f32x16{}; p1 = f32x16{};
  for (int d0 = 0; d0 < 8; ++d0) { int cb = (d0 * 16 + hi * 8) * 2;
    bf16x8 b0 = *reinterpret_cast<const bf16x8*>((const char*)Ks + KSWZ(r32, cb));
    bf16x8 b1 = *reinterpret_cast<const bf16x8*>((const char*)Ks + KSWZ(32 + r32, cb));
    p0 = __builtin_amdgcn_mfma_f32_32x32x16_bf16(b0, qr[d0], p0, 0, 0, 0);
    p1 = __builtin_amdgcn_mfma_f32_32x32x16_bf16(b1, qr[d0], p1, 0, 0, 0); }
}
__device__ __forceinline__ int v_st(int k, int c) { const int kk = (k & ~0xC) | ((k & 4) << 1) | ((k & 8) >> 1); return ((kk >> 3) * 4 + (c >> 5)) * 512 + ((kk & 7) * 32 + (c & 31)) * 2; }
__device__ __forceinline__ int v_rd_base(int lane) { return ((lane & 3) << 3) | (((lane >> 2) & 3) << 6) | (((lane >> 4) & 1) << 5) | (((lane >> 5) & 1) << 8); }
constexpr int v_rd_off(int d0, int ks, int half) { return d0 * 512 + ks * 4096 + half * 2048; }
template <int OFF> __device__ __forceinline__ s16x4 tr_read(int vb) {
  s16x4 r; asm volatile("ds_read_b64_tr_b16 %0, %1 offset:%2" : "=&v"(r) : "v"(vb), "i"(OFF) : "memory"); return r;
}
template <int D0> __device__ __forceinline__ void pv_one(f32x16& od, int vb, bf16x8 pa0, bf16x8 pa1, bf16x8 pa2, bf16x8 pa3) {
  const s16x4 l0 = tr_read<v_rd_off(D0, 0, 0)>(vb), h0 = tr_read<v_rd_off(D0, 0, 1)>(vb), l1 = tr_read<v_rd_off(D0, 1, 0)>(vb), h1 = tr_read<v_rd_off(D0, 1, 1)>(vb);
  const s16x4 l2 = tr_read<v_rd_off(D0, 2, 0)>(vb), h2 = tr_read<v_rd_off(D0, 2, 1)>(vb), l3 = tr_read<v_rd_off(D0, 3, 0)>(vb), h3 = tr_read<v_rd_off(D0, 3, 1)>(vb);
  asm volatile("s_waitcnt lgkmcnt(0)" ::: "memory"); SBAR();
#define PK(L, H) (bf16x8){L[0], L[1], L[2], L[3], H[0], H[1], H[2], H[3]}
  od = __builtin_amdgcn_mfma_f32_32x32x16_bf16(pa0, PK(l0, h0), od, 0, 0, 0);
  od = __builtin_amdgcn_mfma_f32_32x32x16_bf16(pa1, PK(l1, h1), od, 0, 0, 0);
  od = __builtin_amdgcn_mfma_f32_32x32x16_bf16(pa2, PK(l2, h2), od, 0, 0, 0);
  od = __builtin_amdgcn_mfma_f32_32x32x16_bf16(pa3, PK(l3, h3), od, 0, 0, 0);
#undef PK
}
__device__ __forceinline__ void pv_d0(f32x16* o, int vb, bf16x8 pa0, bf16x8 pa1, bf16x8 pa2, bf16x8 pa3) {
  pv_one<0>(o[0], vb, pa0, pa1, pa2, pa3); pv_one<1>(o[1], vb, pa0, pa1, pa2, pa3); pv_one<2>(o[2], vb, pa0, pa1, pa2, pa3); pv_one<3>(o[3], vb, pa0, pa1, pa2, pa3);
}
__device__ __forceinline__ void attn_unit(const bf16* Qb, const bf16* __restrict__ K0, const bf16* __restrict__ V0, int n0, const bf16* __restrict__ K1, const bf16* __restrict__ V1, int ntot, bf16* Ob, char* lds) {
  int tid = threadIdx.x; asm volatile("" : "+v"(tid));
  const int wid = tid >> 6, lane = tid & 63, r32 = lane & 31, hi = lane >> 5;
  bf16* V_lds = (bf16*)lds; bf16* K_lds = (bf16*)(lds + 2 * SHM_V);
  float* ws = (float*)(lds + 2 * SHM_V + 2 * SHM_K) + wid * 64; float* li_l = ws; float* al_l = ws + 32;
  float m_reg = -1e30f, l_reg = 0; f32x16 o[4] = {}; bf16x8 qr[8];
  const bf16* Qw = Qb + (long)(wid * QBLK + r32) * LDQ + hi * 8;
#pragma unroll
  for (int d0 = 0; d0 < 8; ++d0) qr[d0] = *reinterpret_cast<const bf16x8*>(Qw + d0 * 16);
  const int sr = tid >> 4, sc = (tid & 15) * 8, vst0 = v_st(sr, sc), vst1 = v_st(32 + sr, sc);
  const int vb0 = (int)(uintptr_t)V_lds + v_rd_base(lane);
  const unsigned soff = (unsigned)(sr * LDK + sc) * 2u;
  struct { bf16x8 vs0, vs1, ks0, ks1; } sr_[2];
#define SLOAD(i, k0) do { const int k0_ = (k0); const char* kp_ = (const char*)(k0_ < n0 ? K0 + (long)k0_ * LDK : K1 + (long)(k0_ - n0) * LDK); \
    const char* vp_ = (const char*)(k0_ < n0 ? V0 + (long)k0_ * LDK : V1 + (long)(k0_ - n0) * LDK); \
    sr_[i].vs0 = *reinterpret_cast<const bf16x8*>(vp_ + soff); sr_[i].vs1 = *reinterpret_cast<const bf16x8*>(vp_ + 32 * LDK * 2 + soff); \
    sr_[i].ks0 = *reinterpret_cast<const bf16x8*>(kp_ + soff); sr_[i].ks1 = *reinterpret_cast<const bf16x8*>(kp_ + 32 * LDK * 2 + soff); } while (0)
#define SWRITE(b, i) do { *(bf16x8*)((char*)V_lds + (b) * SHM_V + vst0) = sr_[i].vs0;          \
    *(bf16x8*)((char*)V_lds + (b) * SHM_V + vst1) = sr_[i].vs1; int kc = sc * 2;               \
    *(bf16x8*)((char*)K_lds + (b) * SHM_K + KSWZ(sr, kc)) = sr_[i].ks0;                       \
    *(bf16x8*)((char*)K_lds + (b) * SHM_K + KSWZ(32 + sr, kc)) = sr_[i].ks1; } while (0)
#define SWAIT() asm volatile("s_waitcnt vmcnt(4)" ::: "memory")
#define RESC(a) do { if (__any((a) < 1.f)) { if (hi == 0) al_l[r32] = (a); asm volatile("s_waitcnt lgkmcnt(0)" ::: "memory"); \
    for (int d = 0; d < 4; ++d) for (int r = 0; r < 16; ++r) o[d][r] *= al_l[crow(r, hi)]; } } while (0)
  f32x16 pA0, pA1, pB0, pB1; float mnA, mnB, alA, alB; bf16x8 pa0, pa1, pa2, pa3; const int NT = ntot / KVBLK;
  constexpr int SE = 0, SO = 1;
  SLOAD(SE, 0); asm volatile("s_waitcnt vmcnt(0)" ::: "memory"); SWRITE(0, SE); __syncthreads();
  qkt(pA0, pA1, K_lds, qr, r32, hi); partialSM(pA0, pA1, m_reg, mnA, alA);
  SLOAD(SO, KVBLK); if (2 < NT) SLOAD(SE, 2 * KVBLK);
  SWAIT(); SWRITE(1, SO); __syncthreads();
  for (int j = 1; j + 1 < NT; j += 2) {
    SBAR(); qkt(pB0, pB1, (bf16*)((char*)K_lds + SHM_K), qr, r32, hi);
    finishSM(pA0, pA1, alA, l_reg, pa0, pa1, pa2, pa3); SBAR();
    SLOAD(SO, (j + 2) * KVBLK); SBAR();
    pv_d0(o, vb0, pa0, pa1, pa2, pa3); partialSM(pB0, pB1, m_reg, mnB, alB);
    __syncthreads(); SWAIT(); SWRITE(0, SE);
    RESC(alB); __syncthreads();
    SBAR(); qkt(pA0, pA1, K_lds, qr, r32, hi);
    finishSM(pB0, pB1, alB, l_reg, pa0, pa1, pa2, pa3); SBAR();
    if (j + 3 < NT) SLOAD(SE, (j + 3) * KVBLK); SBAR();
    pv_d0(o, vb0 + (int)SHM_V, pa0, pa1, pa2, pa3); partialSM(pA0, pA1, m_reg, mnA, alA);
    __syncthreads(); SWAIT(); SWRITE(1, SO);
    RESC(alA); __syncthreads();
  }
  SBAR(); qkt(pB0, pB1, (bf16*)((char*)K_lds + SHM_K), qr, r32, hi);
  finishSM(pA0, pA1, alA, l_reg, pa0, pa1, pa2, pa3); SBAR();
  pv_d0(o, vb0, pa0, pa1, pa2, pa3); partialSM(pB0, pB1, m_reg, mnB, alB);
  __syncthreads(); RESC(alB);
  finishSM(pB0, pB1, alB, l_reg, pa0, pa1, pa2, pa3); SBAR();
  pv_d0(o, vb0 + (int)SHM_V, pa0, pa1, pa2, pa3);
  if (hi == 0) li_l[r32] = l_reg; asm volatile("s_waitcnt lgkmcnt(0)" ::: "memory");
  float rli[16];
#pragma unroll
  for (int r = 0; r < 16; ++r) rli[r] = __builtin_amdgcn_rcpf(li_l[crow(r, hi)]);
  __syncthreads();
  unsigned short* stg = (unsigned short*)lds + wid * (QBLK * D);
#pragma unroll
  for (int r = 0; r < 16; ++r) { const int orow = crow(r, hi);
#pragma unroll
    for (int d0 = 0; d0 < 4; ++d0) stg[orow * D + d0 * 32 + r32] = (unsigned short)(cvtpk(o[d0][r] * rli[r], 0.f) & 0xffffu); }
  asm volatile("s_waitcnt lgkmcnt(0)" ::: "memory");
  bf16* Ow = Ob + (long)(wid * QBLK) * LDO;
#pragma unroll
  for (int i = 0; i < 8; ++i) { const int row = i * 4 + (lane >> 4), ch = lane & 15; const u32x4 v = *(const u32x4*)(stg + row * D + ch * 8); *(u32x4*)(Ow + (long)row * LDO + ch * 8) = v; }
  __syncthreads();
#undef SLOAD
#undef SWRITE
#undef SWAIT
#undef RESC
}


template <int D0> __device__ __forceinline__ void pv_rd(s16x4 (&l)[4], s16x4 (&h)[4], int vb) {
  l[0] = tr_read<v_rd_off(D0, 0, 0)>(vb); h[0] = tr_read<v_rd_off(D0, 0, 1)>(vb); l[1] = tr_read<v_rd_off(D0, 1, 0)>(vb); h[1] = tr_read<v_rd_off(D0, 1, 1)>(vb);
  l[2] = tr_read<v_rd_off(D0, 2, 0)>(vb); h[2] = tr_read<v_rd_off(D0, 2, 1)>(vb); l[3] = tr_read<v_rd_off(D0, 3, 0)>(vb); h[3] = tr_read<v_rd_off(D0, 3, 1)>(vb);
}
__device__ __forceinline__ void pv_mm(f32x16& od, const s16x4 (&l)[4], const s16x4 (&h)[4], bf16x8 pa0, bf16x8 pa1, bf16x8 pa2, bf16x8 pa3) {
#define PK(L, H) (bf16x8){L[0], L[1], L[2], L[3], H[0], H[1], H[2], H[3]}
  od = __builtin_amdgcn_mfma_f32_32x32x16_bf16(pa0, PK(l[0], h[0]), od, 0, 0, 0);
  od = __builtin_amdgcn_mfma_f32_32x32x16_bf16(pa1, PK(l[1], h[1]), od, 0, 0, 0);
  od = __builtin_amdgcn_mfma_f32_32x32x16_bf16(pa2, PK(l[2], h[2]), od, 0, 0, 0);
  od = __builtin_amdgcn_mfma_f32_32x32x16_bf16(pa3, PK(l[3], h[3]), od, 0, 0, 0);
#undef PK
}
__device__ __forceinline__ void pv_pipe(f32x16* o, int vb, s16x4 (&la)[4], s16x4 (&ha)[4], bf16x8 pa0, bf16x8 pa1, bf16x8 pa2, bf16x8 pa3) {
  s16x4 lb[4], hb[4];
  pv_rd<1>(lb, hb, vb); asm volatile("s_waitcnt lgkmcnt(8)" ::: "memory"); SBAR(); pv_mm(o[0], la, ha, pa0, pa1, pa2, pa3); SBAR();
  pv_rd<2>(la, ha, vb); asm volatile("s_waitcnt lgkmcnt(8)" ::: "memory"); SBAR(); pv_mm(o[1], lb, hb, pa0, pa1, pa2, pa3); SBAR();
  pv_rd<3>(lb, hb, vb); asm volatile("s_waitcnt lgkmcnt(8)" ::: "memory"); SBAR(); pv_mm(o[2], la, ha, pa0, pa1, pa2, pa3); SBAR();
  asm volatile("s_waitcnt lgkmcnt(0)" ::: "memory"); SBAR(); pv_mm(o[3], lb, hb, pa0, pa1, pa2, pa3); SBAR();
}

template <int OFF> __device__ __forceinline__ bf16x8 k_read(int addr) { bf16x8 r; asm volatile("ds_read_b128 %0, %1 offset:%2" : "=&v"(r) : "v"(addr), "i"(OFF) : "memory"); return r; }
template <int G> __device__ __forceinline__ void qk_rd(bf16x8 (&f)[4], const int (&ka)[4]) {
  f[0] = k_read<(G >> 1) * 128>(ka[(2 * G) & 3]);     f[1] = k_read<(G >> 1) * 128 + 8192>(ka[(2 * G) & 3]);
  f[2] = k_read<(G >> 1) * 128>(ka[(2 * G + 1) & 3]); f[3] = k_read<(G >> 1) * 128 + 8192>(ka[(2 * G + 1) & 3]);
}
template <int G> __device__ __forceinline__ void qk_mm(f32x16& p0, f32x16& p1, const bf16x8 (&f)[4], const bf16x8* qr) {
  if constexpr (G == 0) { const f32x16 z = {}; p0 = __builtin_amdgcn_mfma_f32_32x32x16_bf16(f[0], qr[0], z, 0, 0, 0); p1 = __builtin_amdgcn_mfma_f32_32x32x16_bf16(f[1], qr[0], z, 0, 0, 0); }
  else { p0 = __builtin_amdgcn_mfma_f32_32x32x16_bf16(f[0], qr[2 * G], p0, 0, 0, 0); p1 = __builtin_amdgcn_mfma_f32_32x32x16_bf16(f[1], qr[2 * G], p1, 0, 0, 0); }
  p0 = __builtin_amdgcn_mfma_f32_32x32x16_bf16(f[2], qr[2 * G + 1], p0, 0, 0, 0); p1 = __builtin_amdgcn_mfma_f32_32x32x16_bf16(f[3], qr[2 * G + 1], p1, 0, 0, 0);
}
__device__ __forceinline__ void qkt_pipe(f32x16& p0, f32x16& p1, const int (&kb)[4], int kslot, const bf16x8* qr) {
  int ka[4]; ka[0] = kb[0] + kslot; ka[1] = kb[1] + kslot; ka[2] = kb[2] + kslot; ka[3] = kb[3] + kslot;
  bf16x8 fa[4], fb[4];
  qk_rd<0>(fa, ka); qk_rd<1>(fb, ka); asm volatile("s_waitcnt lgkmcnt(4)" ::: "memory"); SBAR(); qk_mm<0>(p0, p1, fa, qr); SBAR();
  qk_rd<2>(fa, ka); asm volatile("s_waitcnt lgkmcnt(4)" ::: "memory"); SBAR(); qk_mm<1>(p0, p1, fb, qr); SBAR();
  qk_rd<3>(fb, ka); asm volatile("s_waitcnt lgkmcnt(4)" ::: "memory"); SBAR(); qk_mm<2>(p0, p1, fa, qr); SBAR();
  asm volatile("s_waitcnt lgkmcnt(0)" ::: "memory"); SBAR(); qk_mm<3>(p0, p1, fb, qr); SBAR();
}
constexpr size_t SHM_ATTN2 = 3 * SHM_V + 3 * SHM_K + NW * 64 * 4;
__device__ __forceinline__ void softmaxY(f32x16& p0, f32x16& p1, float& m_reg, float& l_reg, float& alpha, bf16x8& pa0, bf16x8& pa1, bf16x8& pa2, bf16x8& pa3) {
  float mn; partialSM(p0, p1, m_reg, mn, alpha); finishSM(p0, p1, alpha, l_reg, pa0, pa1, pa2, pa3);
}
__device__ __forceinline__ void attn_unit2(const bf16* Qb, const bf16* __restrict__ K0, const bf16* __restrict__ V0, int n0, const bf16* __restrict__ K1, const bf16* __restrict__ V1, int ntot, bf16* Ob, char* lds) {
  int tid = threadIdx.x; asm volatile("" : "+v"(tid));
  const int wid = tid >> 6, lane = tid & 63, r32 = lane & 31, hi = lane >> 5, grp = __builtin_amdgcn_readfirstlane(wid >> 2);
  bf16* V_lds = (bf16*)lds; bf16* K_lds = (bf16*)(lds + 3 * SHM_V);
  float* ws = (float*)(lds + 3 * SHM_V + 3 * SHM_K) + wid * 64; float* li_l = ws; float* al_l = ws + 32;
  float m_reg = -1e30f, l_reg = 0; f32x16 o[4] = {}; bf16x8 qr[8];
  const bf16* Qw = Qb + (long)(wid * QBLK + r32) * LDQ + hi * 8;
#pragma unroll
  for (int d0 = 0; d0 < 8; ++d0) qr[d0] = *reinterpret_cast<const bf16x8*>(Qw + d0 * 16);
  const int sr = tid >> 4, sc = (tid & 15) * 8, vst0 = v_st(sr, sc), vst1 = v_st(32 + sr, sc);
  const int vb0 = (int)(uintptr_t)V_lds + v_rd_base(lane);
  const unsigned soff = (unsigned)(sr * LDK + sc) * 2u;
  bf16x8 vs0, vs1, ks0, ks1;
  int kb[4];
#pragma unroll
  for (int d = 0; d < 4; ++d) kb[d] = (int)(uintptr_t)K_lds + KSWZ(r32, d * 32 + hi * 16);
#define SLOAD2(k0) do { const int k0_ = (k0); const char* kp_ = (const char*)(k0_ < n0 ? K0 + (long)k0_ * LDK : K1 + (long)(k0_ - n0) * LDK); \
    const char* vp_ = (const char*)(k0_ < n0 ? V0 + (long)k0_ * LDK : V1 + (long)(k0_ - n0) * LDK); \
    vs0 = *reinterpret_cast<const bf16x8*>(vp_ + soff); vs1 = *reinterpret_cast<const bf16x8*>(vp_ + 32 * LDK * 2 + soff); \
    ks0 = *reinterpret_cast<const bf16x8*>(kp_ + soff); ks1 = *reinterpret_cast<const bf16x8*>(kp_ + 32 * LDK * 2 + soff); } while (0)
#define SWRITE2(slot) do { const int so_ = (slot) * (int)SHM_V; const int kc = sc * 2; \
    *(bf16x8*)((char*)V_lds + so_ + vst0) = vs0; *(bf16x8*)((char*)V_lds + so_ + vst1) = vs1; \
    *(bf16x8*)((char*)K_lds + so_ + KSWZ(sr, kc)) = ks0; *(bf16x8*)((char*)K_lds + so_ + KSWZ(32 + sr, kc)) = ks1; } while (0)
#define XBAR() do { asm volatile("s_waitcnt lgkmcnt(0)" ::: "memory"); __builtin_amdgcn_s_barrier(); asm volatile("" ::: "memory"); SBAR(); } while (0)
#define RESC2(a) do { if (__any((a) < 1.f)) { if (hi == 0) al_l[r32] = (a); asm volatile("s_waitcnt lgkmcnt(0)" ::: "memory"); \
    for (int d = 0; d < 4; ++d) for (int r = 0; r < 16; ++r) o[d][r] *= al_l[crow(r, hi)]; } } while (0)
  const int NT = ntot / KVBLK;
  f32x16 p0, p1; float alpha; bf16x8 pa0, pa1, pa2, pa3;
  SLOAD2(0); asm volatile("s_waitcnt vmcnt(0)" ::: "memory"); SWRITE2(0); SLOAD2(KVBLK);
  XBAR();
  if (grp == 1) XBAR();
  SBAR(); qkt_pipe(p0, p1, kb, 0, qr);
  asm volatile("s_waitcnt vmcnt(0)" ::: "memory"); SWRITE2(1); if (2 < NT) SLOAD2(2 * KVBLK);
  XBAR();
  int sj = 0, sj1 = 1, sj2 = 2;
  for (int j = 0; j < NT; ++j) {
    softmaxY(p0, p1, m_reg, l_reg, alpha, pa0, pa1, pa2, pa3); RESC2(alpha);
    XBAR();
    { s16x4 la[4], ha[4]; const int vb = vb0 + sj * (int)SHM_V; pv_rd<0>(la, ha, vb);
      if (j + 1 < NT) qkt_pipe(p0, p1, kb, sj1 * (int)SHM_K, qr);
      pv_pipe(o, vb, la, ha, pa0, pa1, pa2, pa3); }
    if (j + 2 < NT) { asm volatile("s_waitcnt vmcnt(0)" ::: "memory"); SWRITE2(sj2); if (j + 3 < NT) SLOAD2((j + 3) * KVBLK); }
    XBAR();
    { const int t_ = sj; sj = sj1; sj1 = sj2; sj2 = t_; }
  }
  if (grp == 0) XBAR();
  if (hi == 0) li_l[r32] = l_reg; asm volatile("s_waitcnt lgkmcnt(0)" ::: "memory");
  float rli[16];
#pragma unroll
  for (int r = 0; r < 16; ++r) rli[r] = __builtin_amdgcn_rcpf(li_l[crow(r, hi)]);
  unsigned short* stg = (unsigned short*)lds + wid * (QBLK * D);
#pragma unroll
  for (int r = 0; r < 16; ++r) { const int orow = crow(r, hi);
#pragma unroll
    for (int d0 = 0; d0 < 4; ++d0) stg[orow * D + d0 * 32 + r32] = (unsigned short)(cvtpk(o[d0][r] * rli[r], 0.f) & 0xffffu); }
  asm volatile("s_waitcnt lgkmcnt(0)" ::: "memory");
  bf16* Ow = Ob + (long)(wid * QBLK) * LDO;
#pragma unroll
  for (int i = 0; i < 8; ++i) { const int row = i * 4 + (lane >> 4), ch = lane & 15; const u32x4 v = *(const u32x4*)(stg + row * D + ch * 8); *(u32x4*)(Ow + (long)row * LDO + ch * 8) = v; }
  XBAR();
#undef SLOAD2
#undef SWRITE2
#undef XBAR
#undef RESC2
}
#undef KSWZ
#undef SBAR
}
#define RLX_AGENT __ATOMIC_RELAXED, __HIP_MEMORY_SCOPE_AGENT
#define LDS_WAIT() asm volatile("s_waitcnt lgkmcnt(0)" ::: "memory")
#define VM_WAIT() asm volatile("s_waitcnt vmcnt(0)" ::: "memory")
__device__ __forceinline__ unsigned long long rt() { return __builtin_amdgcn_s_memrealtime(); }
#define XB_TMO      128
#define XB_XCNT(j)  (256  + 64 * (j))
#define XB_XSUB(j)  (1280 + 64 * (j))
#define XB_XGEN(j)  (2304 + 64 * (j))
#define XB_TOP      3328
#define XB_TOPGEN   3392
#define XCD_BAR_WORDS 3456
#define XB_SPIN_CAP (1u << 18)

__device__ __forceinline__ unsigned xb_ld(unsigned* p)              { return __hip_atomic_load(p, __ATOMIC_RELAXED, __HIP_MEMORY_SCOPE_AGENT); }
__device__ __forceinline__ unsigned xb_add(unsigned* p, unsigned v) { return __hip_atomic_fetch_add(p, v, __ATOMIC_RELAXED, __HIP_MEMORY_SCOPE_AGENT); }
__device__ __forceinline__ unsigned xb_xcc_id() { return (unsigned)__builtin_amdgcn_s_getreg((3 << 11) | 20) & 0xFu; }
#define XB_SPIN(cond, bar) do { unsigned _sp = 0; while (cond) { __builtin_amdgcn_s_sleep(1); \
    if ((++_sp & 255u) == 0u) { if (xb_ld(&(bar)[XB_TMO])) break; if (_sp > XB_SPIN_CAP) { atomicAdd(&(bar)[XB_TMO], 1u); break; } } } } while (0)

struct XcdBarrier {
    unsigned* bar; unsigned x;
    volatile LAS unsigned* st;
};

__device__ __forceinline__ XcdBarrier xcd_barrier_post(unsigned* bar, volatile LAS unsigned* st) {
    XcdBarrier b; b.bar = bar; b.x = xb_xcc_id(); b.st = st;
    if (threadIdx.x == 0) (void)xb_add(&bar[XB_XCNT(b.x)], 1u);
    return b;
}
__device__ __forceinline__ void xcd_barrier_complete(unsigned* bar, unsigned x, unsigned& nloc, unsigned& nx) {
    const unsigned G = gridDim.x * gridDim.y * gridDim.z;
    unsigned sum, cnt, mine, sp = 0u;
    for (;;) {
        sum = 0u; cnt = 0u; mine = 0u;
#pragma unroll
        for (unsigned j = 0; j < 16; ++j) { const unsigned c = xb_ld(&bar[XB_XCNT(j)]); sum += c; cnt += (c > 0u) ? 1u : 0u; mine = (j == x) ? c : mine; }
        if (sum == G) break;
        __builtin_amdgcn_s_sleep(1);
        if ((++sp & 255u) == 0u) { if (xb_ld(&bar[XB_TMO])) break; if (sp > XB_SPIN_CAP) { atomicAdd(&bar[XB_TMO], 1u); break; } }
    }
    nloc = mine > 0u ? mine : 1u; nx = cnt > 0u ? cnt : 1u;
}

__device__ __forceinline__ void xcd_barrier(const XcdBarrier& b) {
    asm volatile("s_waitcnt vmcnt(0)" ::: "memory");
    __syncthreads();
    if (threadIdx.x == 0) {
        unsigned* bar = b.bar;
        __builtin_amdgcn_s_waitcnt(0);
        unsigned nloc = b.st[0], nx = b.st[1];
        if (nloc == 0u) { xcd_barrier_complete(bar, b.x, nloc, nx); b.st[0] = nloc; b.st[1] = nx; }
        const unsigned old = xb_add(&bar[XB_XSUB(b.x)], 1u);
        const unsigned gen = old / nloc;
        if (old + 1u == (gen + 1u) * nloc) {
            __builtin_amdgcn_fence(__ATOMIC_RELEASE, "agent");
            asm volatile("s_waitcnt vmcnt(0)" ::: "memory");
            const unsigned og = xb_add(&bar[XB_TOP], 1u);
            const unsigned tg = og / nx;
            if (og + 1u == (tg + 1u) * nx) xb_add(&bar[XB_TOPGEN], 1u);
            else XB_SPIN(xb_ld(&bar[XB_TOPGEN]) == tg, bar);
            __builtin_amdgcn_fence(__ATOMIC_ACQUIRE, "agent");
            xb_add(&bar[XB_XGEN(b.x)], 1u);
            asm volatile("s_waitcnt vmcnt(0)" ::: "memory");
        } else {
            XB_SPIN(xb_ld(&bar[XB_XGEN(b.x)]) == gen, bar);
            __builtin_amdgcn_fence(__ATOMIC_ACQUIRE, "agent");
            asm volatile("s_waitcnt vmcnt(0)" ::: "memory");
        }
    }
    __syncthreads();
}
constexpr int RING_BYTES = 131072, XCH_OFF = RING_BYTES, XCH_BYTES = 8192, MISC_OFF = XCH_OFF + XCH_BYTES, LDS_BYTES = 147456;
constexpr int CW_BAR = 4096;
constexpr int PH_PREP = 0, PH_ADA = 1, PH_L0 = 2, PH_PER_LAYER = 8, PH_FINAL = PH_L0 + DEPTH * PH_PER_LAYER, PH_COUNT = PH_FINAL + 1;

__device__ __forceinline__ void ph_attention(unsigned char* ws, int layer, int vcu, char* lds) {
    bf16* QO = (bf16*)(ws + WS_Q); const bf16* KB = (const bf16*)(ws + WS_K); const bf16* VB = (const bf16*)(ws + WS_V);
    const bf16* KC = (const bf16*)(ws + WS_KC); const bf16* VC = (const bf16*)(ws + WS_VC);
    const int xcd = vcu >> 5, j = vcu & 31;
    for (int i = 0; i < 6; ++i) {
        int b, head, kvh, n0, ntot; size_t row0, qrow; const bf16 *k1, *v1;
        if (i < 4) { const int grp = xcd * 4 + i; b = grp >> 2; kvh = grp & 3; head = kvh * 4 + (j >> 3); row0 = (size_t)NCTX + (size_t)b * 2048; qrow = row0 + (size_t)(j & 7) * 256; n0 = 2048; ntot = 2304;
                     k1 = KC + (size_t)((layer * 8 + b) * 256) * DKV + kvh * HD; v1 = VC + (size_t)((layer * 8 + b) * 256) * DKV + kvh * HD; }
        else { const int uc = vcu * 2 + (i - 4); b = uc >> 4; head = uc & 15; kvh = head >> 2; row0 = (size_t)b * 256; qrow = row0; n0 = 256; ntot = 256; k1 = KB; v1 = VB; }
        bf16* q = QO + qrow * DM + head * HD;
        att::attn_unit2(q, KB + row0 * DKV + kvh * HD, VB + row0 * DKV + kvh * HD, n0, k1, v1, ntot, q, lds);
    }
}

struct MkArgs { Params p; int ph_lo, ph_hi; };
__global__ void __launch_bounds__(512, 2) mk_fwd(MkArgs a) {
    extern __shared__ __attribute__((aligned(16))) unsigned char lds_raw[];
    LAS unsigned char* lds = (LAS unsigned char*)lds_raw;
    const Params& p = a.p;
    const int wave = __builtin_amdgcn_readfirstlane((int)threadIdx.x >> 6);
    const int G = gridDim.x, bx = blockIdx.x, vcu = (bx % 8) * (G / 8) + bx / 8;
    if (G != 256) return;
    volatile LAS unsigned* MISC = (volatile LAS unsigned*)(lds + MISC_OFF);
    if (threadIdx.x < 32) MISC[threadIdx.x] = 0u;
    __syncthreads();
    XcdBarrier bar = xcd_barrier_post((unsigned*)(p.ws + WS_CTL) + CW_BAR, MISC + 8);
    const int lo = a.ph_lo, hi = a.ph_hi;
#define PHASE_VARS int tid_l = threadIdx.x, vcu_l = vcu; asm volatile("" : "+v"(tid_l), "+s"(vcu_l)); const int lane = tid_l & 63, gt = vcu_l * 512 + tid_l, gw = vcu_l * 8 + wave, ngw = G * 8, ngt = G * 512; \
                   (void)lane; (void)gt; (void)gw; (void)ngw; (void)ngt; \
                   const __attribute__((address_space(4))) MkArgs* ap_ = (const __attribute__((address_space(4))) MkArgs*)__builtin_amdgcn_kernarg_segment_ptr(); asm volatile("" : "+s"(ap_)); \
                   Params q; q.x_prompt = ap_->p.x_prompt; q.x_sample = ap_->p.x_sample; q.cache_k = ap_->p.cache_k; q.cache_v = ap_->p.cache_v; q.c = ap_->p.c; q.c_ctx = ap_->p.c_ctx; q.w_ada = ap_->p.w_ada; q.b_ada = ap_->p.b_ada; q.norm1 = ap_->p.norm1; q.w_in = ap_->p.w_in; q.q_gain = ap_->p.q_gain; q.k_gain = ap_->p.k_gain; q.conv_w = ap_->p.conv_w; q.conv_b = ap_->p.conv_b; q.w_a = ap_->p.w_a; q.w_b = ap_->p.w_b; q.w_o = ap_->p.w_o; q.norm2 = ap_->p.norm2; q.w_gate = ap_->p.w_gate; q.w_up = ap_->p.w_up; q.w_down = ap_->p.w_down; q.norm_f = ap_->p.norm_f; q.out = ap_->p.out; q.ws = ap_->p.ws; unsigned char* ws = q.ws; float* outp = q.out
#define IN(k) (lo <= (k) && (k) < hi)
#define SEAM(k) do { if ((k) + 1 < hi) xcd_barrier(bar); } while (0)

    if (IN(PH_PREP)) {
        PHASE_VARS;
        ph_ada_partials(q, (LAS float*)lds, gw, ngw, lane, tid_l, 512);
        ph_misc_prep(q, gt, ngt);
        __syncthreads();
        ph_weights(q, (LAS float*)lds + wave * (64 * 33), gw, ngw, lane);
        SEAM(PH_PREP);
    }
    if (IN(PH_ADA)) { PHASE_VARS; ph_ada_reduce(q, gt, ngt); SEAM(PH_ADA); }

    for (int l = 0; l < DEPTH; ++l) {
        const int pb = PH_L0 + l * PH_PER_LAYER;
        if (IN(pb + 0)) { PHASE_VARS; ph_norm(q, l, 0, gw, ngw, lane); SEAM(pb + 0); }
        if (IN(pb + 1)) {
            PHASE_VARS; const unsigned char* wl = ws + WS_W + (size_t)l * W_LAYER;
            pg8::Gemm g{(const bf16*)(ws + WS_HB), (const bf16*)(wl + W_IN), MTOK, NIN, DM}; pg8::StaticOrder S; S.init(MTOK, NIN, G, bx);
            pg8::EpiIn E{ws, outp, q.q_gain + l * HD, q.k_gain + l * HD, (LAS float*)(lds + XCH_OFF), l};
            if (wave < 4) pg8::gemm_phase<pg8::EpiIn, pg8::StaticOrder, true, true, 0>(lds, g, S, E); else pg8::gemm_phase<pg8::EpiIn, pg8::StaticOrder, true, true, 1>(lds, g, S, E);
            SEAM(pb + 1);
        }
        if (IN(pb + 2)) { PHASE_VARS; ph_conv(q, l, gt, ngt); ph_attention(ws, l, vcu, (char*)lds_raw); SEAM(pb + 2); }
        if (IN(pb + 3)) {
            PHASE_VARS; const unsigned char* wl = ws + WS_W + (size_t)l * W_LAYER;
            pg8::Gemm2 g{(const bf16*)(ws + WS_CVB), (const bf16*)(wl + W_A), (const bf16*)(ws + WS_Q), (const bf16*)(wl + W_B), DCONV / 64, DM / 64, DM}; pg8::StaticOrder S; S.init(MTOK, DM, G, bx);
            pg8::MidR Mm{(const bf16*)(ws + WS_R)}; pg8::EpiB2 E{(const bf16*)(ws + WS_SB), (bf16*)(ws + WS_HB)};
            if (wave < 4) pg8::gemm_phase_ab<pg8::MidR, pg8::EpiB2, pg8::StaticOrder, true, true, 0>(lds, g, S, Mm, E); else pg8::gemm_phase_ab<pg8::MidR, pg8::EpiB2, pg8::StaticOrder, true, true, 1>(lds, g, S, Mm, E);
            SEAM(pb + 3);
        }
        if (IN(pb + 4)) {
            PHASE_VARS; const unsigned char* wl = ws + WS_W + (size_t)l * W_LAYER;
            pg8::Gemm g{(const bf16*)(ws + WS_HB), (const bf16*)(wl + W_O), MTOK, DM, DM}; pg8::StaticOrder S; S.init(MTOK, DM, G, bx);
            pg8::EpiRes E{(bf16*)(ws + WS_X), (const float*)(ws + WS_MODS) + (size_t)l * NMOD * 6 * DM, 2, l == 0 ? q.x_prompt : nullptr, l == 0 ? q.x_sample : nullptr};
            if (wave < 4) pg8::gemm_phase<pg8::EpiRes, pg8::StaticOrder, true, true, 0>(lds, g, S, E); else pg8::gemm_phase<pg8::EpiRes, pg8::StaticOrder, true, true, 1>(lds, g, S, E);
            SEAM(pb + 4);
        }
        if (IN(pb + 5)) { PHASE_VARS; ph_norm(q, l, 1, gw, ngw, lane); SEAM(pb + 5); }
        if (IN(pb + 6)) {
            PHASE_VARS; const unsigned char* wl = ws + WS_W + (size_t)l * W_LAYER;
            pg8::Gemm g{(const bf16*)(ws + WS_HB), (const bf16*)(wl + W_GU), MTOK, NGU, DM}; pg8::StaticOrder S; S.init(MTOK, NGU, G, bx);
            pg8::EpiGU E{(bf16*)(ws + WS_ACT)};
            if (wave < 4) pg8::gemm_phase<pg8::EpiGU, pg8::StaticOrder, true, true, 0>(lds, g, S, E); else pg8::gemm_phase<pg8::EpiGU, pg8::StaticOrder, true, true, 1>(lds, g, S, E);
            if (l + 1 < DEPTH && bx >= 128) ph_weights_tail(q, (LAS float*)lds + wave * (64 * 33), l + 1, (bx - 128) * 8 + wave, 1024, lane);
            SEAM(pb + 6);
        }
        if (IN(pb + 7)) {
            PHASE_VARS; const unsigned char* wl = ws + WS_W + (size_t)l * W_LAYER;
            pg8::Gemm g{(const bf16*)(ws + WS_ACT), (const bf16*)(wl + W_D), MTOK, DM, DFF}; pg8::StaticOrder S; S.init(MTOK, DM, G, bx);
            pg8::EpiRes E{(bf16*)(ws + WS_X), (const float*)(ws + WS_MODS) + (size_t)l * NMOD * 6 * DM, 5, nullptr, nullptr};
            if (wave < 4) pg8::gemm_phase<pg8::EpiRes, pg8::StaticOrder, true, true, 0>(lds, g, S, E); else pg8::gemm_phase<pg8::EpiRes, pg8::StaticOrder, true, true, 1>(lds, g, S, E);
            SEAM(pb + 7);
        }
    }
    if (IN(PH_FINAL)) { PHASE_VARS; ph_final_norm(q, gw, ngw, lane); }
#undef IN
#undef SEAM
#undef PHASE_VARS
}
static Params make_params(void* const* d_in, void* d_out, void* d_ws) {
    Params p{};
    p.x_prompt = (const float*)d_in[0]; p.x_sample = (const float*)d_in[1]; p.cache_k = (const float*)d_in[2]; p.cache_v = (const float*)d_in[3];
    p.c = (const float*)d_in[4]; p.c_ctx = (const float*)d_in[5]; p.w_ada = (const float*)d_in[6]; p.b_ada = (const float*)d_in[7]; p.norm1 = (const float*)d_in[8];
    p.w_in = (const float*)d_in[9]; p.q_gain = (const float*)d_in[10]; p.k_gain = (const float*)d_in[11]; p.conv_w = (const float*)d_in[12]; p.conv_b = (const float*)d_in[13];
    p.w_a = (const float*)d_in[14]; p.w_b = (const float*)d_in[15]; p.w_o = (const float*)d_in[16]; p.norm2 = (const float*)d_in[17];
    p.w_gate = (const float*)d_in[18]; p.w_up = (const float*)d_in[19]; p.w_down = (const float*)d_in[20]; p.norm_f = (const float*)d_in[21];
    p.out = (float*)d_out; p.ws = (unsigned char*)d_ws; return p;
}
static void mk_launch(const Params& p, int lo, int hi, int grid, hipStream_t stream) {
    (void)hipMemsetAsync(p.ws + WS_CTL, 0, CTL_ZERO_BYTES, stream);
    MkArgs a{}; a.p = p; a.ph_lo = lo; a.ph_hi = hi;
    hipLaunchKernelGGL(mk_fwd, dim3(grid), dim3(512), LDS_BYTES, stream, a);
    const hipError_t le = hipPeekAtLastError();
    if (le != hipSuccess) fprintf(stderr, "kernel_launch: mk_fwd launch failed: %s (grid %d)\n", hipGetErrorName(le), grid);
}
extern "C" void kernel_launch(void* const* d_in, const int* in_sizes, int n_in, void* d_out, int out_size, void* d_ws, size_t ws_size, hipStream_t stream) {
    static int grid = 0;
    if (grid == 0) {
        if (n_in != 22 || out_size != 83886080 || ws_size < WS_END) { fprintf(stderr, "kernel_launch: unexpected shapes: n_in %d out %d ws %zu (need %zu)\n", n_in, out_size, ws_size, (size_t)WS_END); grid = -1; return; }
        int dev = 0, cus = 0, per_cu = 0;
        if (hipGetDevice(&dev) != hipSuccess || hipDeviceGetAttribute(&cus, hipDeviceAttributeMultiprocessorCount, dev) != hipSuccess) { grid = -1; return; }
        if (hipFuncSetAttribute((const void*)mk_fwd, hipFuncAttributeMaxDynamicSharedMemorySize, LDS_BYTES) != hipSuccess) { fprintf(stderr, "kernel_launch: hipFuncSetAttribute failed\n"); grid = -1; return; }
        if (hipOccupancyMaxActiveBlocksPerMultiprocessor(&per_cu, (const void*)mk_fwd, 512, LDS_BYTES) != hipSuccess || per_cu < 1) fprintf(stderr, "kernel_launch: occupancy query says %d\n", per_cu);
        (void)hipGetLastError();
        grid = cus;
    }
    if (grid < 0) return;
    const Params p = make_params(d_in, d_out, d_ws);
    mk_launch(p, 0, PH_COUNT, grid, stream);
}
```

```cpp
#include <hip/hip_runtime.h>
#include <cstdio>
#include <cstdint>
namespace pg8 {
#define PG8_LAS __attribute__((address_space(3)))
typedef unsigned short bf16_t;
typedef short bf16x8 __attribute__((ext_vector_type(8)));
typedef float f32x4 __attribute__((ext_vector_type(4)));
typedef unsigned u32x4 __attribute__((ext_vector_type(4)));
constexpr int BM = 256, BK = 64, HALF = 128, HTB = HALF * BK * 2  , STAGE_BYTES = 8 * HTB, NXCD = 8, WGM = 8;

__host__ __device__ __forceinline__ int lds_byte(int r, int c) { const int st = (r >> 4) * 2 + (c >> 5), rr = r & 15, cc = c & 31, ob = rr * 64 + cc * 2; return st * 1024 + (ob ^ (((ob >> 9) & 1) << 5)); }
__host__ __device__ __forceinline__ void stage_rc(int b, int& R, int& C) { const int st = b / 1024, sb = b % 1024, swz = sb ^ (((sb >> 9) & 1) << 5); R = (st >> 1) * 16 + swz / 64; C = (st & 1) * 32 + (swz % 64) / 2; }
__host__ __device__ __forceinline__ int perm32(int rho) { const int n = rho >> 4, i = rho & 15; return 8 * (i >> 2) + 4 * n + (i & 3); }

struct Unit { int pm, pn; };
struct Gemm { const bf16_t* A; const bf16_t* Bt; int M, N, K; };

struct StaticOrder {
    int nM, nN, nwg, G, c;
    __host__ __device__ void init(int M, int N, int G_, int c_) { nM = M / BM; nN = N / BM; nwg = nM * nN; G = G_; c = c_; }
    __host__ __device__ bool next(int i, Unit& u) const {
        const long L = (long)i * G + c; if (L >= nwg) return false;
        int wgid = (int)L; { const int q = nwg / NXCD, r = nwg % NXCD, xcd = wgid % NXCD, off = wgid / NXCD; wgid = (xcd < r ? xcd * (q + 1) : r * (q + 1) + (xcd - r) * q) + off; }
        const int nig = WGM * nN, gid = wgid / nig, fm = gid * WGM, gsz = (nM - fm) < WGM ? (nM - fm) : WGM;
        u.pm = fm + ((wgid % nig) % gsz); u.pn = (wgid % nig) / gsz; return true;
    }
    __device__ __forceinline__ void a_ready(const Unit&) const {}
    __device__ __forceinline__ void done(const Unit&) const {}
};

__device__ __forceinline__ unsigned cvt_pk_bf16(float lo, float hi) { unsigned r; asm volatile("v_cvt_pk_bf16_f32 %0, %1, %2" : "=v"(r) : "v"(lo), "v"(hi)); return r; }
template <class Epi, class Sched, bool ALIGN_EPI = false, bool SP2 = false, int WRSEL = 0>
__device__ __forceinline__ void gemm_phase(PG8_LAS unsigned char* lds, const Gemm g, const Sched& S, const Epi& E) {
    int tid = threadIdx.x; asm volatile("" : "+v"(tid));
    const int wid = __builtin_amdgcn_readfirstlane(tid >> 6), lane = tid & 63, wc = wid & 3, fr = lane & 15, fq = lane >> 4; constexpr int wr = WRSEL;
    int K = g.K; asm volatile("" : "+s"(K));     const int nt = K / BK;
    unsigned voffA[2], voffB[2];
#pragma unroll
    for (int i = 0; i < 2; ++i) { int R, C; stage_rc(tid * 16 + i * 8192, R, C); const int Rb = Epi::PERM ? ((R & ~31) + perm32(R & 31)) : R;
        voffA[i] = (unsigned)(R * K + C) * 2u; voffB[i] = (unsigned)(Rb * K + C) * 2u; }
    const size_t kstep = (size_t)(BK * 2);
    const size_t hstep = (size_t)HALF * K * 2;
    const size_t tstep = 2 * hstep;
    const unsigned ldsw = (unsigned)wid * 1024u;
    const int aoff = lds_byte(wr * 64 + fr, fq * 8), boff = lds_byte(wc * 32 + fr, fq * 8);
#define PG8_SA(b, h) (((b) * 2 + (h)) * HTB)
#define PG8_SB(b, h) ((4 + (b) * 2 + (h)) * HTB)
#define PG8_STAGE(bufoff, gbase, voff) do { const char* gb_ = (const char*)(gbase); asm volatile("" : "+s"(gb_));     \
        _Pragma("unroll") for (int _i = 0; _i < 2; ++_i) \
        __builtin_amdgcn_global_load_lds((const unsigned*)(gb_ + (voff)[_i]), (PG8_LAS unsigned*)(lds + (bufoff) + ldsw + _i * 8192), 16, 0, 0); } while (0)
#define PG8_LDA(dst, b, h) do { _Pragma("unroll") for (int m = 0; m < 4; ++m) _Pragma("unroll") for (int k = 0; k < 2; ++k) dst[m][k] = *(const PG8_LAS bf16x8*)(lds + PG8_SA(b, h) + aoff + m * 2048 + k * 1024); } while (0)
#define PG8_LDB(dst, b, h) do { _Pragma("unroll") for (int n = 0; n < 2; ++n) _Pragma("unroll") for (int k = 0; k < 2; ++k) dst[n][k] = *(const PG8_LAS bf16x8*)(lds + PG8_SB(b, h) + boff + n * 2048 + k * 1024); } while (0)
#define PG8_MMA(ai, bj, At, Bt) do { __builtin_amdgcn_s_setprio(1); _Pragma("unroll") for (int m = 0; m < 4; ++m) _Pragma("unroll") for (int n = 0; n < 2; ++n) _Pragma("unroll") for (int k = 0; k < 2; ++k) \
        acc[ai][bj][m][n] = __builtin_amdgcn_mfma_f32_16x16x32_bf16(Bt[n][k], At[m][k], acc[ai][bj][m][n], 0, 0, 0); __builtin_amdgcn_s_setprio(0); } while (0)
#define PG8_MMA0(ai, bj, At, Bt) do { if (zc) { __builtin_amdgcn_s_setprio(1); const f32x4 z4_ = (f32x4){0.f, 0.f, 0.f, 0.f}; _Pragma("unroll") for (int m = 0; m < 4; ++m) _Pragma("unroll") for (int n = 0; n < 2; ++n) { \
        acc[ai][bj][m][n] = __builtin_amdgcn_mfma_f32_16x16x32_bf16(Bt[n][0], At[m][0], z4_, 0, 0, 0); acc[ai][bj][m][n] = __builtin_amdgcn_mfma_f32_16x16x32_bf16(Bt[n][1], At[m][1], acc[ai][bj][m][n], 0, 0, 0); } \
        __builtin_amdgcn_s_setprio(0); } else PG8_MMA(ai, bj, At, Bt); } while (0)
#define PG8_WAIT_V(n) asm volatile("s_waitcnt vmcnt(" #n ")" ::: "memory")
#define PG8_WAIT_L(n) asm volatile("s_waitcnt lgkmcnt(" #n ")" ::: "memory")
#define PG8_BAR __builtin_amdgcn_s_barrier()
#define PG8_SCHED __builtin_amdgcn_sched_barrier(0)
    Unit cur, nxt; int ui = 0;
    if (!S.next(0, cur)) return;
    f32x4 acc[2][2][4][2];
    bf16x8 At[4][2], B0[2][2], B1[2][2];
    const char* cA = (const char*)g.A + (size_t)cur.pm * tstep; const char* cB = (const char*)g.Bt + (size_t)cur.pn * tstep;
    S.a_ready(cur);
    if constexpr (SP2) {
        PG8_STAGE(PG8_SB(0, 0), cB, voffB); PG8_STAGE(PG8_SB(0, 1), cB + hstep, voffB); PG8_STAGE(PG8_SA(0, 0), cA, voffA); PG8_STAGE(PG8_SA(0, 1), cA + hstep, voffA);
        if (wr == 1) PG8_BAR;
        PG8_WAIT_V(2); PG8_BAR;
        PG8_STAGE(PG8_SB(1, 0), cB + kstep, voffB); PG8_STAGE(PG8_SB(1, 1), cB + hstep + kstep, voffB);
        PG8_WAIT_V(6); PG8_BAR;
    } else {
        PG8_STAGE(PG8_SB(0, 0), cB, voffB); PG8_STAGE(PG8_SA(0, 0), cA, voffA); PG8_STAGE(PG8_SB(0, 1), cB + hstep, voffB); PG8_STAGE(PG8_SA(0, 1), cA + hstep, voffA);
        if (wr == 1) PG8_BAR;
        PG8_WAIT_V(4); PG8_BAR;
        PG8_STAGE(PG8_SB(1, 0), cB + kstep, voffB); PG8_STAGE(PG8_SA(1, 0), cA + kstep, voffA); PG8_STAGE(PG8_SB(1, 1), cB + hstep + kstep, voffB);
        PG8_WAIT_V(6); PG8_BAR;
    }
    for (;;) {
        const bool has_next = S.next(ui + 1, nxt);
        const char* nA = has_next ? (const char*)g.A + (size_t)nxt.pm * tstep : cA; const char* nB = has_next ? (const char*)g.Bt + (size_t)nxt.pn * tstep : cB;
        for (int t = 0; t < nt; t += 2) {
            const bool last = (t == nt - 2); const bool zc = (t == 0);
            asm volatile("" : "+v"(voffA[0]), "+v"(voffA[1]), "+v"(voffB[0]), "+v"(voffB[1]));
            const char* a1 = cA + (size_t)(t + 1) * kstep;
            const char* a2 = last ? nA : cA + (size_t)(t + 2) * kstep; const char* b2 = last ? nB : cB + (size_t)(t + 2) * kstep;
            const char* a3 = a2 + kstep; const char* b3 = b2 + kstep;
            if (last && has_next) S.a_ready(nxt);
            if constexpr (SP2) {
            PG8_LDB(B0, 0, 0); PG8_LDB(B1, 0, 1); PG8_SCHED; PG8_LDA(At, 0, 0); PG8_STAGE(PG8_SA(1, 0), a1, voffA); PG8_STAGE(PG8_SA(1, 1), a1 + hstep, voffA);
            PG8_WAIT_V(8); PG8_WAIT_L(0); PG8_BAR; PG8_MMA0(0, 0, At, B0); PG8_MMA0(0, 1, At, B1); PG8_BAR; PG8_SCHED;
            PG8_LDA(At, 0, 1); PG8_STAGE(PG8_SB(0, 0), b2, voffB); PG8_STAGE(PG8_SB(0, 1), b2 + hstep, voffB);
            PG8_WAIT_V(6); PG8_WAIT_L(0); PG8_BAR; PG8_MMA0(1, 0, At, B0); PG8_MMA0(1, 1, At, B1); PG8_BAR; PG8_SCHED;
            PG8_LDB(B0, 1, 0); PG8_LDB(B1, 1, 1); PG8_SCHED; PG8_LDA(At, 1, 0); PG8_STAGE(PG8_SA(0, 0), a2, voffA); PG8_STAGE(PG8_SA(0, 1), a2 + hstep, voffA);
            PG8_WAIT_V(8); PG8_WAIT_L(0); PG8_BAR; PG8_MMA(0, 0, At, B0); PG8_MMA(0, 1, At, B1); PG8_BAR; PG8_SCHED;
            PG8_LDA(At, 1, 1); PG8_STAGE(PG8_SB(1, 0), b3, voffB); PG8_STAGE(PG8_SB(1, 1), b3 + hstep, voffB);
            PG8_WAIT_V(6); PG8_WAIT_L(0); PG8_BAR; PG8_MMA(1, 0, At, B0); PG8_MMA(1, 1, At, B1); PG8_BAR; PG8_SCHED;
            } else {
            PG8_LDB(B0, 0, 0); PG8_SCHED; PG8_LDA(At, 0, 0); PG8_STAGE(PG8_SA(1, 1), a1 + hstep, voffA);
            PG8_WAIT_L(8); PG8_BAR; PG8_WAIT_L(0); PG8_MMA(0, 0, At, B0); PG8_BAR; PG8_SCHED;
            PG8_LDB(B1, 0, 1); PG8_STAGE(PG8_SB(0, 0), b2, voffB);
            PG8_BAR; PG8_WAIT_L(0); PG8_MMA(0, 1, At, B1); PG8_BAR;
            PG8_LDA(At, 0, 1); PG8_STAGE(PG8_SA(0, 0), a2, voffA);
            PG8_BAR; PG8_WAIT_L(0); PG8_MMA(1, 0, At, B0); PG8_BAR; PG8_SCHED;
            PG8_STAGE(PG8_SB(0, 1), b2 + hstep, voffB);
            PG8_WAIT_V(6); PG8_BAR; PG8_MMA(1, 1, At, B1); PG8_BAR;
            PG8_LDB(B0, 1, 0); PG8_SCHED; PG8_LDA(At, 1, 0); PG8_STAGE(PG8_SA(0, 1), a2 + hstep, voffA);
            PG8_WAIT_L(8); PG8_BAR; PG8_WAIT_L(0); PG8_MMA(0, 0, At, B0); PG8_BAR; PG8_SCHED;
            PG8_LDB(B1, 1, 1); PG8_STAGE(PG8_SB(1, 0), b3, voffB);
            PG8_BAR; PG8_WAIT_L(0); PG8_MMA(0, 1, At, B1); PG8_BAR;
            PG8_LDA(At, 1, 1); PG8_STAGE(PG8_SA(1, 0), a3, voffA);
            PG8_BAR; PG8_WAIT_L(0); PG8_MMA(1, 0, At, B0); PG8_BAR; PG8_SCHED;
            PG8_STAGE(PG8_SB(1, 1), b3 + hstep, voffB);
            PG8_WAIT_V(6); PG8_BAR; PG8_MMA(1, 1, At, B1); PG8_BAR;
            }
        }
        if constexpr (ALIGN_EPI) { if (wr == 0) PG8_BAR; }
        if constexpr (!Epi::AFTER_DRAIN) { E(acc, cur, wr, wc, fr, fq); S.done(cur); }
        if (!has_next) break;
        cur = nxt; cA = nA; cB = nB; ++ui;
        if constexpr (ALIGN_EPI) { if (wr == 1) PG8_BAR; }
    }
    PG8_WAIT_V(0);
    if constexpr (!ALIGN_EPI) { if (wr == 0) PG8_BAR; }
    PG8_BAR;
    if constexpr (Epi::AFTER_DRAIN) { E.fused(acc, cur, wr, wc, fr, fq, lds, wid, lane); S.done(cur); }
#undef PG8_SA
#undef PG8_SB
#undef PG8_STAGE
#undef PG8_LDA
#undef PG8_LDB
#undef PG8_MMA
#undef PG8_MMA0
#undef PG8_WAIT_V
#undef PG8_WAIT_L
#undef PG8_BAR
#undef PG8_SCHED
}
struct Gemm2 { const bf16_t *A1, *B1, *A2, *B2; int nt1, nt2, K; };
template <class Mid, class Epi, class Sched, bool ALIGN_EPI = false, bool SP2 = false, int WRSEL = 0>
__device__ __forceinline__ void gemm_phase_ab(PG8_LAS unsigned char* lds, const Gemm2 g, const Sched& S, const Mid& Mm, const Epi& E) {
    int tid = threadIdx.x; asm volatile("" : "+v"(tid));
    const int wid = __builtin_amdgcn_readfirstlane(tid >> 6), lane = tid & 63, wc = wid & 3, fr = lane & 15, fq = lane >> 4; constexpr int wr = WRSEL;
    int K = g.K; asm volatile("" : "+s"(K));     int nt = g.nt1; int seg = 0;
    unsigned voffA[2], voffB[2];
#pragma unroll
    for (int i = 0; i < 2; ++i) { int R, C; stage_rc(tid * 16 + i * 8192, R, C); const int Rb = Epi::PERM ? ((R & ~31) + perm32(R & 31)) : R;
        voffA[i] = (unsigned)(R * K + C) * 2u; voffB[i] = (unsigned)(Rb * K + C) * 2u; }
    const size_t kstep = (size_t)(BK * 2);
    const size_t hstep = (size_t)HALF * K * 2;
    const size_t tstep = 2 * hstep;
    const unsigned ldsw = (unsigned)wid * 1024u;
    const int aoff = lds_byte(wr * 64 + fr, fq * 8), boff = lds_byte(wc * 32 + fr, fq * 8);
#define PG8_SA(b, h) (((b) * 2 + (h)) * HTB)
#define PG8_SB(b, h) ((4 + (b) * 2 + (h)) * HTB)
#define PG8_STAGE(bufoff, gbase, voff) do { const char* gb_ = (const char*)(gbase); asm volatile("" : "+s"(gb_));     \
        _Pragma("unroll") for (int _i = 0; _i < 2; ++_i) \
        __builtin_amdgcn_global_load_lds((const unsigned*)(gb_ + (voff)[_i]), (PG8_LAS unsigned*)(lds + (bufoff) + ldsw + _i * 8192), 16, 0, 0); } while (0)
#define PG8_LDA(dst, b, h) do { _Pragma("unroll") for (int m = 0; m < 4; ++m) _Pragma("unroll") for (int k = 0; k < 2; ++k) dst[m][k] = *(const PG8_LAS bf16x8*)(lds + PG8_SA(b, h) + aoff + m * 2048 + k * 1024); } while (0)
#define PG8_LDB(dst, b, h) do { _Pragma("unroll") for (int n = 0; n < 2; ++n) _Pragma("unroll") for (int k = 0; k < 2; ++k) dst[n][k] = *(const PG8_LAS bf16x8*)(lds + PG8_SB(b, h) + boff + n * 2048 + k * 1024); } while (0)
#define PG8_MMA(ai, bj, At, Bt) do { __builtin_amdgcn_s_setprio(1); _Pragma("unroll") for (int m = 0; m < 4; ++m) _Pragma("unroll") for (int n = 0; n < 2; ++n) _Pragma("unroll") for (int k = 0; k < 2; ++k) \
        acc[ai][bj][m][n] = __builtin_amdgcn_mfma_f32_16x16x32_bf16(Bt[n][k], At[m][k], acc[ai][bj][m][n], 0, 0, 0); __builtin_amdgcn_s_setprio(0); } while (0)
#define PG8_MMA0(ai, bj, At, Bt) do { if (zc) { __builtin_amdgcn_s_setprio(1); const f32x4 z4_ = (f32x4){0.f, 0.f, 0.f, 0.f}; _Pragma("unroll") for (int m = 0; m < 4; ++m) _Pragma("unroll") for (int n = 0; n < 2; ++n) { \
        acc[ai][bj][m][n] = __builtin_amdgcn_mfma_f32_16x16x32_bf16(Bt[n][0], At[m][0], z4_, 0, 0, 0); acc[ai][bj][m][n] = __builtin_amdgcn_mfma_f32_16x16x32_bf16(Bt[n][1], At[m][1], acc[ai][bj][m][n], 0, 0, 0); } \
        __builtin_amdgcn_s_setprio(0); } else PG8_MMA(ai, bj, At, Bt); } while (0)
#define PG8_WAIT_V(n) asm volatile("s_waitcnt vmcnt(" #n ")" ::: "memory")
#define PG8_WAIT_L(n) asm volatile("s_waitcnt lgkmcnt(" #n ")" ::: "memory")
#define PG8_BAR __builtin_amdgcn_s_barrier()
#define PG8_SCHED __builtin_amdgcn_sched_barrier(0)
    Unit cur, nxt; int ui = 0;
    if (!S.next(0, cur)) return;
    f32x4 acc[2][2][4][2];
    bf16x8 At[4][2], B0[2][2], B1[2][2];
    const char* cA = (const char*)g.A1 + (size_t)cur.pm * tstep; const char* cB = (const char*)g.B1 + (size_t)cur.pn * tstep;
    S.a_ready(cur);
    if constexpr (SP2) {
        PG8_STAGE(PG8_SB(0, 0), cB, voffB); PG8_STAGE(PG8_SB(0, 1), cB + hstep, voffB); PG8_STAGE(PG8_SA(0, 0), cA, voffA); PG8_STAGE(PG8_SA(0, 1), cA + hstep, voffA);
        if (wr == 1) PG8_BAR;
        PG8_WAIT_V(2); PG8_BAR;
        PG8_STAGE(PG8_SB(1, 0), cB + kstep, voffB); PG8_STAGE(PG8_SB(1, 1), cB + hstep + kstep, voffB);
        PG8_WAIT_V(6); PG8_BAR;
    } else {
        PG8_STAGE(PG8_SB(0, 0), cB, voffB); PG8_STAGE(PG8_SA(0, 0), cA, voffA); PG8_STAGE(PG8_SB(0, 1), cB + hstep, voffB); PG8_STAGE(PG8_SA(0, 1), cA + hstep, voffA);
        if (wr == 1) PG8_BAR;
        PG8_WAIT_V(4); PG8_BAR;
        PG8_STAGE(PG8_SB(1, 0), cB + kstep, voffB); PG8_STAGE(PG8_SA(1, 0), cA + kstep, voffA); PG8_STAGE(PG8_SB(1, 1), cB + hstep + kstep, voffB);
        PG8_WAIT_V(6); PG8_BAR;
    }
    for (;;) {
        bool has_next; const char* nA; const char* nB; int nnt;
        if (seg == 0) { has_next = true; nA = (const char*)g.A2 + (size_t)cur.pm * tstep; nB = (const char*)g.B2 + (size_t)cur.pn * tstep; nnt = g.nt2; }
        else { has_next = S.next(ui + 1, nxt); nA = has_next ? (const char*)g.A1 + (size_t)nxt.pm * tstep : cA; nB = has_next ? (const char*)g.B1 + (size_t)nxt.pn * tstep : cB; nnt = g.nt1; }
        for (int t = 0; t < nt; t += 2) {
            const bool last = (t == nt - 2); const bool zc = (t == 0) && (seg == 0);
            asm volatile("" : "+v"(voffA[0]), "+v"(voffA[1]), "+v"(voffB[0]), "+v"(voffB[1]));
            const char* a1 = cA + (size_t)(t + 1) * kstep;
            const char* a2 = last ? nA : cA + (size_t)(t + 2) * kstep; const char* b2 = last ? nB : cB + (size_t)(t + 2) * kstep;
            const char* a3 = a2 + kstep; const char* b3 = b2 + kstep;
            if (last && has_next) S.a_ready(nxt);
            if constexpr (SP2) {
            PG8_LDB(B0, 0, 0); PG8_LDB(B1, 0, 1); PG8_SCHED; PG8_LDA(At, 0, 0); PG8_STAGE(PG8_SA(1, 0), a1, voffA); PG8_STAGE(PG8_SA(1, 1), a1 + hstep, voffA);
            PG8_WAIT_V(8); PG8_WAIT_L(0); PG8_BAR; PG8_MMA0(0, 0, At, B0); PG8_MMA0(0, 1, At, B1); PG8_BAR; PG8_SCHED;
            PG8_LDA(At, 0, 1); PG8_STAGE(PG8_SB(0, 0), b2, voffB); PG8_STAGE(PG8_SB(0, 1), b2 + hstep, voffB);
            PG8_WAIT_V(6); PG8_WAIT_L(0); PG8_BAR; PG8_MMA0(1, 0, At, B0); PG8_MMA0(1, 1, At, B1); PG8_BAR; PG8_SCHED;
            PG8_LDB(B0, 1, 0); PG8_LDB(B1, 1, 1); PG8_SCHED; PG8_LDA(At, 1, 0); PG8_STAGE(PG8_SA(0, 0), a2, voffA); PG8_STAGE(PG8_SA(0, 1), a2 + hstep, voffA);
            PG8_WAIT_V(8); PG8_WAIT_L(0); PG8_BAR; PG8_MMA(0, 0, At, B0); PG8_MMA(0, 1, At, B1); PG8_BAR; PG8_SCHED;
            PG8_LDA(At, 1, 1); PG8_STAGE(PG8_SB(1, 0), b3, voffB); PG8_STAGE(PG8_SB(1, 1), b3 + hstep, voffB);
            PG8_WAIT_V(6); PG8_WAIT_L(0); PG8_BAR; PG8_MMA(1, 0, At, B0); PG8_MMA(1, 1, At, B1); PG8_BAR; PG8_SCHED;
            } else {
            PG8_LDB(B0, 0, 0); PG8_SCHED; PG8_LDA(At, 0, 0); PG8_STAGE(PG8_SA(1, 1), a1 + hstep, voffA);
            PG8_WAIT_L(8); PG8_BAR; PG8_WAIT_L(0); PG8_MMA(0, 0, At, B0); PG8_BAR; PG8_SCHED;
            PG8_LDB(B1, 0, 1); PG8_STAGE(PG8_SB(0, 0), b2, voffB);
            PG8_BAR; PG8_WAIT_L(0); PG8_MMA(0, 1, At, B1); PG8_BAR;
            PG8_LDA(At, 0, 1); PG8_STAGE(PG8_SA(0, 0), a2, voffA);
            PG8_BAR; PG8_WAIT_L(0); PG8_MMA(1, 0, At, B0); PG8_BAR; PG8_SCHED;
            PG8_STAGE(PG8_SB(0, 1), b2 + hstep, voffB);
            PG8_WAIT_V(6); PG8_BAR; PG8_MMA(1, 1, At, B1); PG8_BAR;
            PG8_LDB(B0, 1, 0); PG8_SCHED; PG8_LDA(At, 1, 0); PG8_STAGE(PG8_SA(0, 1), a2 + hstep, voffA);
            PG8_WAIT_L(8); PG8_BAR; PG8_WAIT_L(0); PG8_MMA(0, 0, At, B0); PG8_BAR; PG8_SCHED;
            PG8_LDB(B1, 1, 1); PG8_STAGE(PG8_SB(1, 0), b3, voffB);
            PG8_BAR; PG8_WAIT_L(0); PG8_MMA(0, 1, At, B1); PG8_BAR;
            PG8_LDA(At, 1, 1); PG8_STAGE(PG8_SA(1, 0), a3, voffA);
            PG8_BAR; PG8_WAIT_L(0); PG8_MMA(1, 0, At, B0); PG8_BAR; PG8_SCHED;
            PG8_STAGE(PG8_SB(1, 1), b3 + hstep, voffB);
            PG8_WAIT_V(6); PG8_BAR; PG8_MMA(1, 1, At, B1); PG8_BAR;
            }
        }
        if constexpr (ALIGN_EPI) { if (wr == 0) PG8_BAR; }
        if (seg == 0) Mm(acc, cur, wr, wc, fr, fq); else { E(acc, cur, wr, wc, fr, fq); S.done(cur); }
        if (!has_next) break;
        if (seg == 1) { cur = nxt; ++ui; }
        cA = nA; cB = nB; nt = nnt; seg ^= 1;
        if constexpr (ALIGN_EPI) { if (wr == 1) PG8_BAR; }
    }
    PG8_WAIT_V(0);
    if constexpr (!ALIGN_EPI) { if (wr == 0) PG8_BAR; }
    PG8_BAR;
#undef PG8_SA
#undef PG8_SB
#undef PG8_STAGE
#undef PG8_LDA
#undef PG8_LDB
#undef PG8_MMA
#undef PG8_MMA0
#undef PG8_WAIT_V
#undef PG8_WAIT_L
#undef PG8_BAR
#undef PG8_SCHED
}
}
#define GAS __attribute__((address_space(1)))
#define LAS __attribute__((address_space(3)))
typedef unsigned short bf16;
typedef unsigned v4u __attribute__((ext_vector_type(4)));
typedef unsigned v2u __attribute__((ext_vector_type(2)));
typedef float f32x4 __attribute__((ext_vector_type(4)));
typedef short bf16x8 __attribute__((ext_vector_type(8)));

constexpr int DM = 2048, NCTX = 8192, NLAT = 16384, MTOK = 24576, DEPTH = 4;
constexpr int NH = 16, NKV = 4, HD = 128, DKV = 512, DCONV = 1024, DFF = 5632;
constexpr int NIN = 10240, NGU = 11264, NMOD = 9, ADA_N = 12288;
constexpr float EPS = 1e-6f;

constexpr size_t MiB = 1u << 20;
constexpr size_t WS_CTL = 0, CTL_ZERO_BYTES = 32768;
constexpr size_t WS_MODS = 1 * MiB;
constexpr size_t WS_ROPE = 3 * MiB;
constexpr size_t WS_PART = 4 * MiB;
constexpr size_t WS_KC = 18 * MiB, WS_VC = 26 * MiB;
constexpr size_t WS_W = 34 * MiB;
constexpr size_t W_LAYER = 130 * MiB, W_IN = 0, W_A = 40 * MiB, W_B = 48 * MiB, W_O = 56 * MiB, W_GU = 64 * MiB, W_D = 108 * MiB;
constexpr size_t WS_HB = 554 * MiB;
constexpr size_t WS_Q = 650 * MiB;
constexpr size_t WS_K = 746 * MiB, WS_V = 770 * MiB;
constexpr size_t WS_CVB = 794 * MiB;
constexpr size_t WS_U = 890 * MiB;
constexpr size_t WS_R = 938 * MiB, WS_SB = 1034 * MiB;
constexpr size_t WS_ACT = 1130 * MiB;
constexpr size_t WS_X = 1394 * MiB;
constexpr size_t WS_END = 1490 * MiB;
constexpr int LDCV = 2048;
constexpr size_t OUT_YS = (size_t)NCTX * DM, OUT_NK = (size_t)MTOK * DM, OUT_NV = OUT_NK + (size_t)32 * 4 * 256 * 512;

struct Params {
    const float *x_prompt, *x_sample, *cache_k, *cache_v, *c, *c_ctx, *w_ada, *b_ada, *norm1, *w_in, *q_gain, *k_gain, *conv_w, *conv_b,
                *w_a, *w_b, *w_o, *norm2, *w_gate, *w_up, *w_down, *norm_f;
    float* out; unsigned char* ws;
};

__device__ __forceinline__ unsigned f2bf(float f) { unsigned u = __builtin_bit_cast(unsigned, f); return (u + 0x7fffu + ((u >> 16) & 1u)) >> 16; }
__device__ __forceinline__ unsigned pk2(float lo, float hi) { return f2bf(lo) | (f2bf(hi) << 16); }
__device__ __forceinline__ float bf2f(unsigned b) { return __builtin_bit_cast(float, b << 16); }
__device__ __forceinline__ float bflo(unsigned w) { return __builtin_bit_cast(float, w << 16); }
__device__ __forceinline__ float bfhi(unsigned w) { return __builtin_bit_cast(float, w & 0xffff0000u); }
__device__ __forceinline__ float wave_sum(float v) {
#define SWZ_XOR(k) v += __builtin_bit_cast(float, __builtin_amdgcn_ds_swizzle(__builtin_bit_cast(int, v), 0x1F | ((k) << 10)))
    SWZ_XOR(1); SWZ_XOR(2); SWZ_XOR(4); SWZ_XOR(8); SWZ_XOR(16);
#undef SWZ_XOR
    return __builtin_bit_cast(float, __builtin_amdgcn_readlane(__builtin_bit_cast(int, v), 0)) + __builtin_bit_cast(float, __builtin_amdgcn_readlane(__builtin_bit_cast(int, v), 32));
}
__device__ __forceinline__ float sigmoidf_(float v) { return 1.f / (1.f + __expf(-v)); }

__host__ __device__ __forceinline__ int c8_of_ph(int ph) { const int wc = ph >> 5, n = (ph >> 4) & 1, fq = (ph >> 2) & 3, j = ph & 3; return 32 * wc + 8 * fq + 4 * n + j; }
__host__ __device__ __forceinline__ int ph_of_c8(int c) { const int wc = c >> 5, fq = (c >> 3) & 3, n = (c >> 2) & 1, j = c & 3; return 32 * wc + 16 * n + 4 * fq + j; }
__host__ __device__ __forceinline__ int d_of_ph(int ph) { const int wc = ph >> 5, n = (ph >> 4) & 1, fq = (ph >> 2) & 3, j = ph & 3; return 16 * wc + 4 * fq + j + 64 * n; }
__host__ __device__ __forceinline__ int ph_of_d(int d) { const int n = d >> 6, r = d & 63, wc = r >> 4, fq = (r >> 2) & 3, j = r & 3; return 32 * wc + 16 * n + 4 * fq + j; }
__host__ __device__ __forceinline__ int s_of_d(int d) { return c8_of_ph(ph_of_d(d)); }
__host__ __device__ __forceinline__ int d_of_s(int s) { return d_of_ph(ph_of_c8(s)); }
__host__ __device__ __forceinline__ int win_col(int np) {
    const int tile = np >> 8, bj = (np >> 7) & 1, ph = np & 127;
    if (tile < 8)  return (2 * tile + bj) * 128 + d_of_ph(ph);
    if (tile < 10) return 2048 + (2 * (tile - 8) + bj) * 128 + d_of_ph(ph);
    if (tile < 12) return 2560 + (tile - 10) * 256 + bj * 128 + c8_of_ph(ph);
    if (tile < 16) return 3072 + (tile - 12) * 256 + bj * 128 + c8_of_ph(ph);
    if (tile < 24) return (bj ? 5120 : 4096) + (tile - 16) * 128 + c8_of_ph(ph);
    return (bj ? 8192 : 6144) + (tile - 24) * 128 + c8_of_ph(ph);
}
__device__ __forceinline__ int mod_index(int m) { return m < NCTX ? 0 : 1 + ((m - NCTX) >> 11); }

__device__ __forceinline__ void ph_ada_partials(const Params& p, LAS float* st, int gw, int ngw, int lane, int tid, int nthr) {
    for (int i = tid; i < NMOD * DM; i += nthr) { const int ci = i / DM, d = i % DM; const float v = ci == 0 ? p.c_ctx[d] : p.c[(ci - 1) * DM + d]; st[d * 12 + ci] = v / (1.f + expf(-v)); }
    __syncthreads();
    float* PART = (float*)(p.ws + WS_PART);
    for (int it = gw; it < DEPTH * 48 * 8; it += ngw) {
        const int ks = it & 7, cb = (it >> 3) % 48, l = it / (8 * 48);
        const float* w = p.w_ada + ((size_t)l * DM + ks * 256) * ADA_N + cb * 256 + lane * 4;
        f32x4 acc[NMOD];
#pragma unroll
        for (int ci = 0; ci < NMOD; ++ci) acc[ci] = (f32x4){0.f, 0.f, 0.f, 0.f};
#pragma unroll 8
        for (int d = 0; d < 256; ++d) {
            const f32x4 wv = *(const f32x4*)(w + (size_t)d * ADA_N); const LAS float* s = st + (ks * 256 + d) * 12;
            const f32x4 s0 = *(const LAS f32x4*)s, s1 = *(const LAS f32x4*)(s + 4); const float s8 = s[8];
            acc[0] += s0[0] * wv; acc[1] += s0[1] * wv; acc[2] += s0[2] * wv; acc[3] += s0[3] * wv;
            acc[4] += s1[0] * wv; acc[5] += s1[1] * wv; acc[6] += s1[2] * wv; acc[7] += s1[3] * wv; acc[8] += s8 * wv;
        }
#pragma unroll
        for (int ci = 0; ci < NMOD; ++ci) *(f32x4*)(PART + ((size_t)((ks * DEPTH + l) * NMOD + ci)) * ADA_N + cb * 256 + lane * 4) = acc[ci];
    }
}
__device__ __forceinline__ void ph_ada_reduce(const Params& p, int gt, int ngt) {
    const float* PART = (const float*)(p.ws + WS_PART); float* MODS = (float*)(p.ws + WS_MODS);
    for (int i = gt; i < DEPTH * NMOD * (ADA_N / 4); i += ngt) {
        const int e4 = i % (ADA_N / 4), ci = (i / (ADA_N / 4)) % NMOD, l = i / ((ADA_N / 4) * NMOD);
        f32x4 s = *(const f32x4*)(p.b_ada + (size_t)l * ADA_N + e4 * 4);
#pragma unroll
        for (int ks = 0; ks < 8; ++ks) s += *(const f32x4*)(PART + ((size_t)((ks * DEPTH + l) * NMOD + ci)) * ADA_N + e4 * 4);
        *(f32x4*)(MODS + ((size_t)(l * NMOD + ci)) * ADA_N + e4 * 4) = s;
    }
}
__device__ __forceinline__ const float* x_in_row(const Params& p, int m) { return m < NCTX ? p.x_prompt + (size_t)m * DM : p.x_sample + (size_t)(m - NCTX) * DM; }
__device__ __forceinline__ void ph_misc_prep(const Params& p, int gt, int ngt) {
    float* RC = (float*)(p.ws + WS_ROPE); float* RS = RC + 2048 * 64;
    for (int i = gt; i < 2048 * 64; i += ngt) { const int t = i >> 6, ii = i & 63, f = ii & 31; const float inv = powf(10000.0f, -(float)f / 32.0f);
        const float ang = (ii < 32 ? (float)(t >> 6) : (float)(t & 63)) * inv; float sn, cs; sincosf(ang, &sn, &cs); RC[i] = cs; RS[i] = sn; }
    bf16* KC = (bf16*)(p.ws + WS_KC); bf16* VC = (bf16*)(p.ws + WS_VC);
    for (int i = gt; i < DEPTH * 8 * 256 * 64; i += ngt) {
        const int g8 = i & 15, kvh = (i >> 4) & 3, t = (i >> 6) & 255, b = (i >> 14) & 7, l = i >> 17;
        const size_t src = ((((size_t)b * DEPTH + l) * 256 + t) * NKV + kvh) * HD, dst = (((size_t)l * 8 + b) * 256 + t) * DKV + kvh * HD + g8 * 8;
        { const f32x4 a = *(const f32x4*)(p.cache_v + src + g8 * 8), c = *(const f32x4*)(p.cache_v + src + g8 * 8 + 4);
          *(v4u*)(VC + dst) = (v4u){pk2(a[0], a[1]), pk2(a[2], a[3]), pk2(c[0], c[1]), pk2(c[2], c[3])}; }
        { const int d0 = d_of_s(g8 * 8);
          const f32x4 a = *(const f32x4*)(p.cache_k + src + d0), c = *(const f32x4*)(p.cache_k + src + d0 + 64);
          *(v4u*)(KC + dst) = (v4u){pk2(a[0], a[1]), pk2(a[2], a[3]), pk2(c[0], c[1]), pk2(c[2], c[3])}; }
    }
}
__device__ __forceinline__ void wt_item(const float* W0, const float* W1, int K, int Nsrc, int Nphys, int kind, bf16* WT, int ldo, LAS float* scr, int item, int lane) {
    const int nblk = Nphys / 32, kb = item / nblk, nb = item % nblk, k0 = 64 * kb, n0 = 32 * nb;
    const int g = lane & 7, kq = lane >> 3, np = n0 + 4 * g; const float* W = W0; int col;
    if (kind == 0) col = np;
    else if (kind == 1) col = (np & ~127) | c8_of_ph(np & 127);
    else if (kind == 2) col = win_col(np);
    else { col = (np >> 8) * 128 + c8_of_ph(np & 127); if ((np >> 7) & 1) W = W1; }
    f32x4 v[8];
#pragma unroll
    for (int i = 0; i < 8; ++i) v[i] = *(const f32x4*)(W + (size_t)(k0 + 8 * i + kq) * Nsrc + col);
#pragma unroll
    for (int i = 0; i < 8; ++i)
#pragma unroll
        for (int j = 0; j < 4; ++j) scr[(8 * i + kq) * 33 + 4 * g + j] = v[i][j];
    asm volatile("s_waitcnt lgkmcnt(0)" ::: "memory");
    const int c = lane & 7;
#pragma unroll
    for (int j = 0; j < 4; ++j) { const int n = (lane >> 3) + 8 * j; const LAS float* s = scr + (8 * c) * 33 + n;
        v4u o; o.x = pk2(s[0 * 33], s[1 * 33]); o.y = pk2(s[2 * 33], s[3 * 33]); o.z = pk2(s[4 * 33], s[5 * 33]); o.w = pk2(s[6 * 33], s[7 * 33]);
        *(v4u*)(WT + (size_t)(n0 + n) * ldo + k0 + 8 * c) = o; }
    asm volatile("s_waitcnt lgkmcnt(0)" ::: "memory");
}
constexpr int WI_IN = (DM / 64) * (NIN / 32), WI_A = (DCONV / 64) * (DM / 32), WI_B = (DM / 64) * (DM / 32), WI_O = WI_B, WI_GU = (DM / 64) * (NGU / 32), WI_D = (DFF / 64) * (DM / 32);
constexpr int WI_LAYER = WI_IN + WI_A + WI_B + WI_O + WI_GU + WI_D;
constexpr int WI_TAIL = 8192;
__device__ __forceinline__ void wt_dispatch(const Params& p, LAS float* scr, int l, int r, int lane) {
    unsigned char* wl = p.ws + WS_W + (size_t)l * W_LAYER;
    if (r < WI_IN) { wt_item(p.w_in + (size_t)l * DM * NIN, nullptr, DM, NIN, NIN, 2, (bf16*)(wl + W_IN), DM, scr, r, lane); return; } r -= WI_IN;
    if (r < WI_A)  { wt_item(p.w_a + (size_t)l * DCONV * DM, nullptr, DCONV, DM, DM, 1, (bf16*)(wl + W_A), DM  , scr, r, lane); return; } r -= WI_A;
    if (r < WI_B)  { wt_item(p.w_b + (size_t)l * DM * DM, nullptr, DM, DM, DM, 1, (bf16*)(wl + W_B), DM, scr, r, lane); return; } r -= WI_B;
    if (r < WI_O)  { wt_item(p.w_o + (size_t)l * DM * DM, nullptr, DM, DM, DM, 1, (bf16*)(wl + W_O), DM, scr, r, lane); return; } r -= WI_O;
    if (r < WI_GU) { wt_item(p.w_gate + (size_t)l * DM * DFF, p.w_up + (size_t)l * DM * DFF, DM, DFF, NGU, 3, (bf16*)(wl + W_GU), DM, scr, r, lane); return; } r -= WI_GU;
    wt_item(p.w_down + (size_t)l * DFF * DM, nullptr, DFF, DM, DM, 1, (bf16*)(wl + W_D), DFF, scr, r, lane);
}
__device__ __forceinline__ void ph_weights(const Params& p, LAS float* scr  , int gw, int ngw, int lane) {
    constexpr int PER = WI_LAYER - WI_TAIL, TOT = WI_LAYER + (DEPTH - 1) * PER;
    for (int it = gw; it < TOT; it += ngw) {
        int l = 0, r = it; if (it >= WI_LAYER) { l = 1 + (it - WI_LAYER) / PER; r = (it - WI_LAYER) % PER; }
        wt_dispatch(p, scr, l, r, lane);
    }
}
__device__ __forceinline__ void ph_weights_tail(const Params& p, LAS float* scr, int l, int tw, int ntw, int lane) {
    for (int it = WI_LAYER - WI_TAIL + tw; it < WI_LAYER; it += ntw) wt_dispatch(p, scr, l, it, lane);
}
__device__ __forceinline__ void norm_load_row(const Params& p, bool from_in, int m, int lane, f32x4 (&v)[8]) {
    if (from_in) { const float* xr = x_in_row(p, m);
#pragma unroll
        for (int j = 0; j < 8; ++j) v[j] = *(const f32x4*)(xr + ((j >> 1) * 64 + lane) * 8 + (j & 1) * 4); }
    else { const bf16* xr = (const bf16*)(p.ws + WS_X) + (size_t)m * DM;
#pragma unroll
        for (int jj = 0; jj < 4; ++jj) { const v4u w = *(const v4u*)(xr + (jj * 64 + lane) * 8);
            v[2 * jj] = (f32x4){bflo(w[0]), bfhi(w[0]), bflo(w[1]), bfhi(w[1])}; v[2 * jj + 1] = (f32x4){bflo(w[2]), bfhi(w[2]), bflo(w[3]), bfhi(w[3])}; } }
}
__device__ __forceinline__ void ph_norm(const Params& p, int layer, int which, int gw, int ngw, int lane) {
    const float* g = (which ? p.norm2 : p.norm1) + (size_t)layer * DM; const float* MODS = (const float*)(p.ws + WS_MODS); bf16* HB = (bf16*)(p.ws + WS_HB);
    constexpr int rpw = MTOK / 2048; const int m0 = gw * rpw; (void)ngw; const bool from_in = (layer == 0 && which == 0);
    f32x4 gs[8], sh[8], v[8], vn[8]; int ci_cur = -1;
    norm_load_row(p, from_in, m0, lane, v);
    for (int r = 0; r < rpw; ++r) {
        const int m = m0 + r, ci = mod_index(m);
        if (ci != ci_cur) { ci_cur = ci; const float* mod = MODS + ((size_t)(layer * NMOD + ci) * 6 + 3 * which) * DM;
#pragma unroll
            for (int j = 0; j < 8; ++j) { const int c = ((j >> 1) * 64 + lane) * 8 + (j & 1) * 4; sh[j] = *(const f32x4*)(mod + c); gs[j] = *(const f32x4*)(g + c) * (*(const f32x4*)(mod + DM + c) + 1.0f); } }
        if (r + 1 < rpw) norm_load_row(p, from_in, m + 1, lane, vn);
        float ss = 0.f;
#pragma unroll
        for (int j = 0; j < 8; ++j) ss += (v[j][0] * v[j][0] + v[j][1] * v[j][1]) + (v[j][2] * v[j][2] + v[j][3] * v[j][3]);
        const float rstd = 1.0f / sqrtf(wave_sum(ss) * (1.0f / DM) + EPS);
#pragma unroll
        for (int jj = 0; jj < 4; ++jj) { const f32x4 y0 = (v[2 * jj] * rstd) * gs[2 * jj] + sh[2 * jj], y1 = (v[2 * jj + 1] * rstd) * gs[2 * jj + 1] + sh[2 * jj + 1];
            *(v4u*)(HB + (size_t)m * DM + (jj * 64 + lane) * 8) = (v4u){pk2(y0[0], y0[1]), pk2(y0[2], y0[3]), pk2(y1[0], y1[1]), pk2(y1[2], y1[3])}; }
#pragma unroll
        for (int j = 0; j < 8; ++j) v[j] = vn[j];
    }
}
__device__ __forceinline__ void ph_conv(const Params& p, int layer, int gt, int ngt) {
    bf16* CVB = (bf16*)(p.ws + WS_CVB); const bf16* U = (const bf16*)(p.ws + WS_U);
    const int ch0 = (gt & 127) * 8; const float* cw = p.conv_w + (size_t)layer * 3 * DCONV + ch0; const float* cb = p.conv_b + (size_t)layer * DCONV + ch0;
    float w0[8], w1[8], w2[8], wb[8];
#pragma unroll
    for (int k = 0; k < 8; ++k) { w0[k] = cw[k]; w1[k] = cw[DCONV + k]; w2[k] = cw[2 * DCONV + k]; wb[k] = cb[k]; }
    for (int i = gt; i < MTOK * (DCONV / 8); i += ngt) {
        const int m = i >> 7; int t, S; if (m < NCTX) { t = m & 255; S = 256; } else { t = (m - NCTX) & 2047; S = 2048; }
        const v4u z = (v4u){0u, 0u, 0u, 0u};
        const v4u b8 = *(const v4u*)(CVB + (size_t)m * LDCV + ch0), u0 = *(const v4u*)(U + (size_t)m * DCONV + ch0);
        const v4u um = t > 0 ? *(const v4u*)(U + (size_t)(m - 1) * DCONV + ch0) : z, up = t < S - 1 ? *(const v4u*)(U + (size_t)(m + 1) * DCONV + ch0) : z;
        float y[8];
#pragma unroll
        for (int k = 0; k < 8; ++k) { const int w = k >> 1; const bool hi = k & 1;
            const float bv = hi ? bfhi(b8[w]) : bflo(b8[w]), a0 = hi ? bfhi(u0[w]) : bflo(u0[w]), am = hi ? bfhi(um[w]) : bflo(um[w]), ap = hi ? bfhi(up[w]) : bflo(up[w]);
            y[k] = bv * (w0[k] * am + w1[k] * a0 + w2[k] * ap + wb[k]); }
        *(v4u*)(CVB + (size_t)m * LDCV + ch0) = (v4u){pk2(y[0], y[1]), pk2(y[2], y[3]), pk2(y[4], y[5]), pk2(y[6], y[7])};
    }
}
__device__ __forceinline__ void ph_final_norm(const Params& p, int gw, int ngw, int lane) {
    constexpr int rpw = MTOK / 2048; const int m0 = gw * rpw; (void)ngw; f32x4 gf[8], v[8], vn[8];
#pragma unroll
    for (int j = 0; j < 8; ++j) gf[j] = *(const f32x4*)(p.norm_f + ((j >> 1) * 64 + lane) * 8 + (j & 1) * 4);
    norm_load_row(p, false, m0, lane, v);
    for (int r = 0; r < rpw; ++r) {
        float* yr = p.out + (size_t)(m0 + r) * DM;
        if (r + 1 < rpw) norm_load_row(p, false, m0 + r + 1, lane, vn);
        float ss = 0.f;
#pragma unroll
        for (int j = 0; j < 8; ++j) ss += (v[j][0] * v[j][0] + v[j][1] * v[j][1]) + (v[j][2] * v[j][2] + v[j][3] * v[j][3]);
        const float rstd = 1.0f / sqrtf(wave_sum(ss) * (1.0f / DM) + EPS);
#pragma unroll
        for (int j = 0; j < 8; ++j) *(f32x4*)(yr + ((j >> 1) * 64 + lane) * 8 + (j & 1) * 4) = (v[j] * rstd) * gf[j];
#pragma unroll
        for (int j = 0; j < 8; ++j) v[j] = vn[j];
    }
}
namespace pg8 {
typedef unsigned u32x4e __attribute__((ext_vector_type(4)));
__device__ __forceinline__ u32x4e pack8(const f32x4 a, const f32x4 b) { u32x4e w; w.x = cvt_pk_bf16(a[0], a[1]); w.y = cvt_pk_bf16(a[2], a[3]); w.z = cvt_pk_bf16(b[0], b[1]); w.w = cvt_pk_bf16(b[2], b[3]); return w; }
__device__ __forceinline__ f32x4 unpack_lo(const u32x4e w) { return (f32x4){__builtin_bit_cast(float, w.x << 16), __builtin_bit_cast(float, w.x & 0xffff0000u), __builtin_bit_cast(float, w.y << 16), __builtin_bit_cast(float, w.y & 0xffff0000u)}; }
__device__ __forceinline__ f32x4 unpack_hi(const u32x4e w) { return (f32x4){__builtin_bit_cast(float, w.z << 16), __builtin_bit_cast(float, w.z & 0xffff0000u), __builtin_bit_cast(float, w.w << 16), __builtin_bit_cast(float, w.w & 0xffff0000u)}; }
__device__ __forceinline__ float fsig(float v) { return __builtin_amdgcn_rcpf(1.0f + __builtin_amdgcn_exp2f(-1.4426950408889634f * v)); }
__device__ __forceinline__ f32x4 fsig4(const f32x4 v) { return (f32x4){fsig(v[0]), fsig(v[1]), fsig(v[2]), fsig(v[3])}; }

struct EpiIn {
    static constexpr bool PERM = false, AFTER_DRAIN = false;
    unsigned char* ws_; float* out_; const float *qg, *kg; PG8_LAS float* P; int layer;
    __device__ __forceinline__ void operator()(const f32x4 (&acc)[2][2][4][2], const Unit& u, int wr, int wc, int fr, int fq) const {
        asm volatile("" : "+v"(fr), "+v"(fq));
        const int pn = u.pn, cq = wc * 32 + fq * 8; const bool lat = u.pm >= 32;
        GAS unsigned char* wsg = (GAS unsigned char*)ws_; GAS float* outg = (GAS float*)out_; asm volatile("" : "+s"(wsg), "+s"(outg));
        unsigned char* ws = (unsigned char*)wsg; float* outp = (float*)outg;
        bf16_t* const QB = (bf16_t*)(ws + WS_Q); bf16_t* const KB = (bf16_t*)(ws + WS_K); bf16_t* const VB = (bf16_t*)(ws + WS_V); bf16_t* const CVB = (bf16_t*)(ws + WS_CVB); bf16_t* const U = (bf16_t*)(ws + WS_U);
        bf16_t* const RR = (bf16_t*)(ws + WS_R); bf16_t* const SB = (bf16_t*)(ws + WS_SB); const float* const RC = (const float*)(ws + WS_ROPE); const float* const RS = RC + 2048 * 64;
        float* const NK = outp + OUT_NK; float* const NV = outp + OUT_NV;
        if (pn < 10) {
            const bool isk = pn >= 8; const float* gain = isk ? kg : qg;
            const f32x4 g0 = *(const f32x4*)(gain + wc * 16 + fq * 4), g1 = *(const f32x4*)(gain + 64 + wc * 16 + fq * 4);
#pragma unroll
            for (int ai = 0; ai < 2; ++ai)
#pragma unroll
                for (int m = 0; m < 4; ++m)
#pragma unroll
                    for (int bj = 0; bj < 2; ++bj) { const f32x4 a = acc[ai][bj][m][0], b = acc[ai][bj][m][1];
                        float s = ((a[0] * a[0] + a[1] * a[1]) + (a[2] * a[2] + a[3] * a[3])) + ((b[0] * b[0] + b[1] * b[1]) + (b[2] * b[2] + b[3] * b[3]));
                        s += __builtin_bit_cast(float, __builtin_amdgcn_ds_bpermute(((fq ^ 1) * 16 + fr) << 2, __builtin_bit_cast(int, s))); s += __builtin_bit_cast(float, __builtin_amdgcn_ds_bpermute(((fq ^ 2) * 16 + fr) << 2, __builtin_bit_cast(int, s)));
                        if (fq == 0) P[((ai * HALF + wr * 64 + m * 16 + fr) * 2 + bj) * 4 + wc] = s; }
            asm volatile("s_waitcnt lgkmcnt(0)" ::: "memory"); __builtin_amdgcn_s_barrier(); asm volatile("" ::: "memory");
#pragma unroll
            for (int ai = 0; ai < 2; ++ai) { f32x4 csv[4], snv[4];
#pragma unroll
                for (int m = 0; m < 4; ++m) { csv[m] = (f32x4){1.f, 1.f, 1.f, 1.f}; snv[m] = (f32x4){0.f, 0.f, 0.f, 0.f};
                    if (lat) { const int t = (u.pm * BM + ai * HALF + wr * 64 + m * 16 + fr - 8192) & 2047; csv[m] = *(const f32x4*)(RC + t * 64 + wc * 16 + fq * 4); snv[m] = *(const f32x4*)(RS + t * 64 + wc * 16 + fq * 4); } }
#pragma unroll
                for (int m = 0; m < 4; ++m) { const int r = ai * HALF + wr * 64 + m * 16 + fr, mrow = u.pm * BM + r; const f32x4 cs = csv[m], sn = snv[m];
#pragma unroll
                    for (int bj = 0; bj < 2; ++bj) { const f32x4 pp = *(const PG8_LAS f32x4*)(P + (r * 2 + bj) * 4);
                        const float rstd = 1.0f / sqrtf(((pp[0] + pp[1]) + (pp[2] + pp[3])) * (1.0f / 128.0f) + 1e-6f);
                        f32x4 y1 = acc[ai][bj][m][0] * rstd * g0, y2 = acc[ai][bj][m][1] * rstd * g1;
                        if (lat) { const f32x4 a = y1 * cs - y2 * sn, b = y2 * cs + y1 * sn; y1 = a; y2 = b; }
                        const int head = 2 * (pn - (isk ? 8 : 0)) + bj;
                        bf16_t* dst = isk ? KB + (size_t)mrow * 512 + head * 128 : QB + (size_t)mrow * 2048 + head * 128;
                        *(u32x4e*)(dst + cq) = pack8(y1, y2);
                        if (isk && !lat) { float* nk = NK + ((size_t)((mrow >> 8) * 4 + layer) * 256 + (mrow & 255)) * 512 + head * 128 + wc * 16 + fq * 4; *(f32x4*)nk = y1; *(f32x4*)(nk + 64) = y2; } } } }
        } else if (pn < 16) {
            const bool isv = pn < 12; const int ld = isv ? 512 : LDCV, ct = (isv ? pn - 10 : pn - 12) * 256; bf16_t* base = isv ? VB : CVB;
#pragma unroll
            for (int ai = 0; ai < 2; ++ai)
#pragma unroll
                for (int m = 0; m < 4; ++m) { const int mrow = u.pm * BM + ai * HALF + wr * 64 + m * 16 + fr;
#pragma unroll
                    for (int bj = 0; bj < 2; ++bj) { *(u32x4e*)(base + (size_t)mrow * ld + ct + bj * HALF + cq) = pack8(acc[ai][bj][m][0], acc[ai][bj][m][1]);
                        if (isv && !lat) { float* nv = NV + ((size_t)((mrow >> 8) * 4 + layer) * 256 + (mrow & 255)) * 512 + ct + bj * HALF + cq; *(f32x4*)nv = acc[ai][bj][m][0]; *(f32x4*)(nv + 4) = acc[ai][bj][m][1]; } } }
        } else if (pn < 24) {
#pragma unroll
            for (int ai = 0; ai < 2; ++ai)
#pragma unroll
                for (int m = 0; m < 4; ++m) { const int mrow = u.pm * BM + ai * HALF + wr * 64 + m * 16 + fr;
                    *(u32x4e*)(U + (size_t)mrow * 1024 + (pn - 16) * 128 + cq) = pack8(acc[ai][0][m][0] * acc[ai][1][m][0], acc[ai][0][m][1] * acc[ai][1][m][1]); }
        } else {
#pragma unroll
            for (int ai = 0; ai < 2; ++ai)
#pragma unroll
                for (int m = 0; m < 4; ++m) { const size_t o = (size_t)(u.pm * BM + ai * HALF + wr * 64 + m * 16 + fr) * 2048 + (pn - 24) * 128 + cq;
                    f32x4 rr[2], sb[2];
#pragma unroll
                    for (int n = 0; n < 2; ++n)
#pragma unroll
                        for (int j = 0; j < 4; ++j) { const float da = 1.0f + __builtin_amdgcn_exp2f(-1.4426950408889634f * acc[ai][0][m][n][j]), db = 1.0f + __builtin_amdgcn_exp2f(-1.4426950408889634f * acc[ai][1][m][n][j]);
                            rr[n][j] = db * __builtin_amdgcn_rcpf(da); sb[n][j] = __builtin_amdgcn_rcpf(db); }
                    *(u32x4e*)(RR + o) = pack8(rr[0], rr[1]);
                    *(u32x4e*)(SB + o) = pack8(sb[0], sb[1]); }
        }
    }
};
struct MidR {
    const bf16_t* RR;
    __device__ __forceinline__ void operator()(f32x4 (&acc)[2][2][4][2], const Unit& u, int wr, int wc, int fr, int fq) const {
        asm volatile("" : "+v"(fr), "+v"(fq));
#pragma unroll
        for (int ai = 0; ai < 2; ++ai) { u32x4e s[4][2];
#pragma unroll
            for (int m = 0; m < 4; ++m)
#pragma unroll
                for (int bj = 0; bj < 2; ++bj) s[m][bj] = *(const u32x4e*)(RR + (size_t)(u.pm * BM + ai * HALF + wr * 64 + m * 16 + fr) * 2048 + u.pn * BM + bj * HALF + wc * 32 + fq * 8);
#pragma unroll
            for (int m = 0; m < 4; ++m)
#pragma unroll
                for (int bj = 0; bj < 2; ++bj) { acc[ai][bj][m][0] *= unpack_lo(s[m][bj]); acc[ai][bj][m][1] *= unpack_hi(s[m][bj]); } }
    }
};
struct EpiB2 {
    static constexpr bool PERM = false, AFTER_DRAIN = false;
    const bf16_t* SB; bf16_t* MG;
    __device__ __forceinline__ void operator()(const f32x4 (&acc)[2][2][4][2], const Unit& u, int wr, int wc, int fr, int fq) const {
        asm volatile("" : "+v"(fr), "+v"(fq));
#pragma unroll
        for (int ai = 0; ai < 2; ++ai) { u32x4e s[4][2];
#pragma unroll
            for (int m = 0; m < 4; ++m)
#pragma unroll
                for (int bj = 0; bj < 2; ++bj) s[m][bj] = *(const u32x4e*)(SB + (size_t)(u.pm * BM + ai * HALF + wr * 64 + m * 16 + fr) * 2048 + u.pn * BM + bj * HALF + wc * 32 + fq * 8);
#pragma unroll
            for (int m = 0; m < 4; ++m)
#pragma unroll
                for (int bj = 0; bj < 2; ++bj) *(u32x4e*)(MG + (size_t)(u.pm * BM + ai * HALF + wr * 64 + m * 16 + fr) * 2048 + u.pn * BM + bj * HALF + wc * 32 + fq * 8) = pack8(unpack_lo(s[m][bj]) * acc[ai][bj][m][0], unpack_hi(s[m][bj]) * acc[ai][bj][m][1]); }
    }
};
struct EpiRes {
    static constexpr bool PERM = false, AFTER_DRAIN = false;
    bf16_t* XB; const float* mods; int chunk; const float* xp32; const float* xs32;
    __device__ __forceinline__ void operator()(const f32x4 (&acc)[2][2][4][2], const Unit& u, int wr, int wc, int fr, int fq) const {
        asm volatile("" : "+v"(fr), "+v"(fq));
        const int ci = u.pm < 32 ? 0 : 1 + ((u.pm - 32) >> 3); const float* gt = mods + ((size_t)ci * 6 + chunk) * 2048;
        const int col0 = u.pn * BM + wc * 32 + 8 * fq; f32x4 gv[2][2];
#pragma unroll
        for (int bj = 0; bj < 2; ++bj)
#pragma unroll
            for (int n = 0; n < 2; ++n) gv[bj][n] = *(const f32x4*)(gt + col0 + bj * HALF + n * 4);
        if (xp32) {
            const float* xin = u.pm < 32 ? xp32 + (size_t)(u.pm * BM) * 2048 : xs32 + (size_t)(u.pm * BM - 8192) * 2048;
#pragma unroll
            for (int ai = 0; ai < 2; ++ai)
#pragma unroll
                for (int mh = 0; mh < 2; ++mh) { f32x4 t[2][2][2];
#pragma unroll
                    for (int m2 = 0; m2 < 2; ++m2)
#pragma unroll
                        for (int bj = 0; bj < 2; ++bj)
#pragma unroll
                            for (int n = 0; n < 2; ++n) t[m2][bj][n] = *(const f32x4*)(xin + (size_t)(ai * HALF + wr * 64 + (2 * mh + m2) * 16 + fr) * 2048 + col0 + bj * HALF + n * 4);
#pragma unroll
                    for (int m2 = 0; m2 < 2; ++m2)
#pragma unroll
                        for (int bj = 0; bj < 2; ++bj) *(u32x4e*)(XB + (size_t)(u.pm * BM + ai * HALF + wr * 64 + (2 * mh + m2) * 16 + fr) * 2048 + col0 + bj * HALF) =
                            pack8(t[m2][bj][0] + gv[bj][0] * acc[ai][bj][2 * mh + m2][0], t[m2][bj][1] + gv[bj][1] * acc[ai][bj][2 * mh + m2][1]); }
            return;
        }
        u32x4e s[2][4][2];
#pragma unroll
        for (int ai = 0; ai < 2; ++ai)
#pragma unroll
            for (int m = 0; m < 4; ++m)
#pragma unroll
                for (int bj = 0; bj < 2; ++bj) s[ai][m][bj] = *(const u32x4e*)(XB + (size_t)(u.pm * BM + ai * HALF + wr * 64 + m * 16 + fr) * 2048 + col0 + bj * HALF);
#pragma unroll
        for (int ai = 0; ai < 2; ++ai)
#pragma unroll
            for (int m = 0; m < 4; ++m)
#pragma unroll
                for (int bj = 0; bj < 2; ++bj) *(u32x4e*)(XB + (size_t)(u.pm * BM + ai * HALF + wr * 64 + m * 16 + fr) * 2048 + col0 + bj * HALF) =
                    pack8(unpack_lo(s[ai][m][bj]) + gv[bj][0] * acc[ai][bj][m][0], unpack_hi(s[ai][m][bj]) + gv[bj][1] * acc[ai][bj][m][1]);
    }
};
struct EpiGU {
    static constexpr bool PERM = false, AFTER_DRAIN = false;
    bf16_t* ACT;
    __device__ __forceinline__ void operator()(const f32x4 (&acc)[2][2][4][2], const Unit& u, int wr, int wc, int fr, int fq) const {
        asm volatile("" : "+v"(fr), "+v"(fq));
#pragma unroll
        for (int ai = 0; ai < 2; ++ai)
#pragma unroll
            for (int m = 0; m < 4; ++m) { const f32x4 g0 = acc[ai][0][m][0], g1 = acc[ai][0][m][1];
                *(u32x4e*)(ACT + (size_t)(u.pm * BM + ai * HALF + wr * 64 + m * 16 + fr) * 5632 + u.pn * 128 + wc * 32 + fq * 8) = pack8(g0 * fsig4(g0) * acc[ai][1][m][0], g1 * fsig4(g1) * acc[ai][1][m][1]); }
    }
};
}
namespace att {
using bf16x8 = __attribute__((ext_vector_type(8))) short;
using s16x4  = __attribute__((ext_vector_type(4))) short;
using f32x16 = __attribute__((ext_vector_type(16))) float;
using u32x4  = __attribute__((ext_vector_type(4))) unsigned;
constexpr int   D = 128, NW = 8, QBLK = 32, KVBLK = 64, LDQ = 2048, LDK = 512, LDO = 2048;
constexpr float SCALE = 0.088388347648318440f, THR = 8.f;
constexpr size_t SHM_V = KVBLK * D * 2, SHM_K = KVBLK * D * 2, SHM_ATTN = 2 * SHM_V + 2 * SHM_K + NW * 64 * 4;
#define KSWZ(row, colB) ((row) * 256 + ((colB) ^ (((row) & 7) << 4)))
#define SBAR() __builtin_amdgcn_sched_barrier(0)
__device__ __forceinline__ int crow(int r, int hi) { return (r & 3) + 8 * (r >> 2) + 4 * hi; }
__device__ __forceinline__ unsigned cvtpk(float lo, float hi) { unsigned r; asm volatile("v_cvt_pk_bf16_f32 %0, %1, %2" : "=v"(r) : "v"(lo), "v"(hi)); return r; }
__device__ __forceinline__ void partialSM(f32x16& p0, f32x16& p1, float& m_reg, float& mn, float& alpha) {
  constexpr float C = SCALE * 1.4426950408889634f;
  float pmax = p0[0]; for (int r = 1; r < 16; ++r) pmax = fmaxf(pmax, p0[r]); for (int r = 0; r < 16; ++r) pmax = fmaxf(pmax, p1[r]);
  { auto rr = __builtin_amdgcn_permlane32_swap(__float_as_uint(pmax), __float_as_uint(pmax), false, false);
    pmax = fmaxf(__uint_as_float(rr[0]), __uint_as_float(rr[1])); }
  if (__builtin_expect(__all(pmax - m_reg <= THR / SCALE), 1)) { mn = m_reg; alpha = 1.f; }
  else { mn = fmaxf(m_reg, pmax); alpha = __builtin_amdgcn_exp2f((m_reg - mn) * C); m_reg = mn; }
  float mnC = -mn * C;
  for (int r = 0; r < 16; ++r) p0[r] = fmaf(p0[r], C, mnC); for (int r = 0; r < 16; ++r) p1[r] = fmaf(p1[r], C, mnC);
  for (int r = 0; r < 16; ++r) p0[r] = __builtin_amdgcn_exp2f(p0[r]);
}
__device__ __forceinline__ void finishSM(f32x16& p0, f32x16& p1, float alpha, float& l_reg, bf16x8& pa0, bf16x8& pa1, bf16x8& pa2, bf16x8& pa3) {
  for (int r = 0; r < 16; ++r) p1[r] = __builtin_amdgcn_exp2f(p1[r]);
  float ps = 0; for (int r = 0; r < 16; ++r) ps += p0[r]; for (int r = 0; r < 16; ++r) ps += p1[r];
  { auto rr = __builtin_amdgcn_permlane32_swap(__float_as_uint(ps), __float_as_uint(ps), false, false);
    ps = __uint_as_float(rr[0]) + __uint_as_float(rr[1]); }
  l_reg = l_reg * alpha + ps;
#define PK4(P, BASE, OUT) do { unsigned a0 = cvtpk(P[BASE + 0], P[BASE + 1]), a1 = cvtpk(P[BASE + 2], P[BASE + 3]);   \
    unsigned b0 = cvtpk(P[BASE + 4], P[BASE + 5]), b1 = cvtpk(P[BASE + 6], P[BASE + 7]);                              \
    auto r0 = __builtin_amdgcn_permlane32_swap(a0, b0, false, false); auto r1 = __builtin_amdgcn_permlane32_swap(a1, b1, false, false); \
    u32x4 w = {r0[0], r1[0], r0[1], r1[1]}; OUT = *reinterpret_cast<bf16x8*>(&w); } while (0)
  PK4(p0, 0, pa0); PK4(p0, 8, pa1); PK4(p1, 0, pa2); PK4(p1, 8, pa3);
#undef PK4
}
__device__ __forceinline__ void qkt(f32x16& p0, f32x16& p1, const bf16* Ks, const bf16x8* qr, int r32, int hi) {
  p0 = f32x16{}; p1 = f32x16{};
  for (int d0 = 0; d0 < 8; ++d0) { int cb = (d0 * 16 + hi * 8) * 2;
    bf16x8 b0 = *reinterpret_cast<const bf16x8*>((const char*)Ks + KSWZ(r32, cb));
    bf16x8 b1 = *reinterpret_cast<const bf16x8*>((const char*)Ks + KSWZ(32 + r32, cb));
    p0 = __builtin_amdgcn_mfma_f32_32x32x16_bf16(b0, qr[d0], p0, 0, 0, 0);
    p1 = __builtin_amdgcn_mfma_f32_32x32x16_bf16(b1, qr[d0], p1, 0, 0, 0); }
}
__device__ __forceinline__ int v_st(int k, int c) { const int kk = (k & ~0xC) | ((k & 4) << 1) | ((k & 8) >> 1); return ((kk >> 3) * 4 + (c >> 5)) * 512 + ((kk & 7) * 32 + (c & 31)) * 2; }
__device__ __forceinline__ int v_rd_base(int lane) { return ((lane & 3) << 3) | (((lane >> 2) & 3) << 6) | (((lane >> 4) & 1) << 5) | (((lane >> 5) & 1) << 8); }
constexpr int v_rd_off(int d0, int ks, int half) { return d0 * 512 + ks * 4096 + half * 2048; }
template <int OFF> __device__ __forceinline__ s16x4 tr_read(int vb) {
  s16x4 r; asm volatile("ds_read_b64_tr_b16 %0, %1 offset:%2" : "=&v"(r) : "v"(vb), "i"(OFF) : "memory"); return r;
}
template <int D0> __device__ __forceinline__ void pv_one(f32x16& od, int vb, bf16x8 pa0, bf16x8 pa1, bf16x8 pa2, bf16x8 pa3) {
  const s16x4 l0 = tr_read<v_rd_off(D0, 0, 0)>(vb), h0 = tr_read<v_rd_off(D0, 0, 1)>(vb), l1 = tr_read<v_rd_off(D0, 1, 0)>(vb), h1 = tr_read<v_rd_off(D0, 1, 1)>(vb);
  const s16x4 l2 = tr_read<v_rd_off(D0, 2, 0)>(vb), h2 = tr_read<v_rd_off(D0, 2, 1)>(vb), l3 = tr_read<v_rd_off(D0, 3, 0)>(vb), h3 = tr_read<v_rd_off(D0, 3, 1)>(vb);
  asm volatile("s_waitcnt lgkmcnt(0)" ::: "memory"); SBAR();
#define PK(L, H) (bf16x8){L[0], L[1], L[2], L[3], H[0], H[1], H[2], H[3]}
  od = __builtin_amdgcn_mfma_f32_32x32x16_bf16(pa0, PK(l0, h0), od, 0, 0, 0);
  od = __builtin_amdgcn_mfma_f32_32x32x16_bf16(pa1, PK(l1, h1), od, 0, 0, 0);
  od = __builtin_amdgcn_mfma_f32_32x32x16_bf16(pa2, PK(l2, h2), od, 0, 0, 0);
  od = __builtin_amdgcn_mfma_f32_32x32x16_bf16(pa3, PK(l3, h3), od, 0, 0, 0);
#undef PK
}
__device__ __forceinline__ void pv_d0(f32x16* o, int vb, bf16x8 pa0, bf16x8 pa1, bf16x8 pa2, bf16x8 pa3) {
  pv_one<0>(o[0], vb, pa0, pa1, pa2, pa3); pv_one<1>(o[1], vb, pa0, pa1, pa2, pa3); pv_one<2>(o[2], vb, pa0, pa1, pa2, pa3); pv_one<3>(o[3], vb, pa0, pa1, pa2, pa3);
}
__device__ __forceinline__ void attn_unit(const bf16* Qb, const bf16* __restrict__ K0, const bf16* __restrict__ V0, int n0, const bf16* __restrict__ K1, const bf16* __restrict__ V1, int ntot, bf16* Ob, char* lds) {
  int tid = threadIdx.x; asm volatile("" : "+v"(tid));
  const int wid = tid >> 6, lane = tid & 63, r32 = lane & 31, hi = lane >> 5;
  bf16* V_lds = (bf16*)lds; bf16* K_lds = (bf16*)(lds + 2 * SHM_V);
  float* ws = (float*)(lds + 2 * SHM_V + 2 * SHM_K) + wid * 64; float* li_l = ws; float* al_l = ws + 32;
  float m_reg = -1e30f, l_reg = 0; f32x16 o[4] = {}; bf16x8 qr[8];
  const bf16* Qw = Qb + (long)(wid * QBLK + r32) * LDQ + hi * 8;
#pragma unroll
  for (int d0 = 0; d0 < 8; ++d0) qr[d0] = *reinterpret_cast<const bf16x8*>(Qw + d0 * 16);
  const int sr = tid >> 4, sc = (tid & 15) * 8, vst0 = v_st(sr, sc), vst1 = v_st(32 + sr, sc);
  const int vb0 = (int)(uintptr_t)V_lds + v_rd_base(lane);
  const unsigned soff = (unsigned)(sr * LDK + sc) * 2u;
  struct { bf16x8 vs0, vs1, ks0, ks1; } sr_[2];
#define SLOAD(i, k0) do { const int k0_ = (k0); const char* kp_ = (const char*)(k0_ < n0 ? K0 + (long)k0_ * LDK : K1 + (long)(k0_ - n0) * LDK); \
    const char* vp_ = (const char*)(k0_ < n0 ? V0 + (long)k0_ * LDK : V1 + (long)(k0_ - n0) * LDK); \
    sr_[i].vs0 = *reinterpret_cast<const bf16x8*>(vp_ + soff); sr_[i].vs1 = *reinterpret_cast<const bf16x8*>(vp_ + 32 * LDK * 2 + soff); \
    sr_[i].ks0 = *reinterpret_cast<const bf16x8*>(kp_ + soff); sr_[i].ks1 = *reinterpret_cast<const bf16x8*>(kp_ + 32 * LDK * 2 + soff); } while (0)
#define SWRITE(b, i) do { *(bf16x8*)((char*)V_lds + (b) * SHM_V + vst0) = sr_[i].vs0;          \
    *(bf16x8*)((char*)V_lds + (b) * SHM_V + vst1) = sr_[i].vs1; int kc = sc * 2;               \
    *(bf16x8*)((char*)K_lds + (b) * SHM_K + KSWZ(sr, kc)) = sr_[i].ks0;                       \
    *(bf16x8*)((char*)K_lds + (b) * SHM_K + KSWZ(32 + sr, kc)) = sr_[i].ks1; } while (0)
#define SWAIT() asm volatile("s_waitcnt vmcnt(4)" ::: "memory")
#define RESC(a) do { if (__any((a) < 1.f)) { if (hi == 0) al_l[r32] = (a); asm volatile("s_waitcnt lgkmcnt(0)" ::: "memory"); \
    for (int d = 0; d < 4; ++d) for (int r = 0; r < 16; ++r) o[d][r] *= al_l[crow(r, hi)]; } } while (0)
  f32x16 pA0, pA1, pB0, pB1; float mnA, mnB, alA, alB; bf16x8 pa0, pa1, pa2, pa3; const int NT = ntot / KVBLK;
  constexpr int SE = 0, SO = 1;
  SLOAD(SE, 0); asm volatile("s_waitcnt vmcnt(0)" ::: "memory"); SWRITE(0, SE); __syncthreads();
  qkt(pA0, pA1, K_lds, qr, r32, hi); partialSM(pA0, pA1, m_reg, mnA, alA);
  SLOAD(SO, KVBLK); if (2 < NT) SLOAD(SE, 2 * KVBLK);
  SWAIT(); SWRITE(1, SO); __syncthreads();
  for (int j = 1; j + 1 < NT; j += 2) {
    SBAR(); qkt(pB0, pB1, (bf16*)((char*)K_lds + SHM_K), qr, r32, hi);
    finishSM(pA0, pA1, alA, l_reg, pa0, pa1, pa2, pa3); SBAR();
    SLOAD(SO, (j + 2) * KVBLK); SBAR();
    pv_d0(o, vb0, pa0, pa1, pa2, pa3); partialSM(pB0, pB1, m_reg, mnB, alB);
    __syncthreads(); SWAIT(); SWRITE(0, SE);
    RESC(alB); __syncthreads();
    SBAR(); qkt(pA0, pA1, K_lds, qr, r32, hi);
    finishSM(pB0, pB1, alB, l_reg, pa0, pa1, pa2, pa3); SBAR();
    if (j + 3 < NT) SLOAD(SE, (j + 3) * KVBLK); SBAR();
    pv_d0(o, vb0 + (int)SHM_V, pa0, pa1, pa2, pa3); partialSM(pA0, pA1, m_reg, mnA, alA);
    __syncthreads(); SWAIT(); SWRITE(1, SO);
    RESC(alA); __syncthreads();
  }
  SBAR(); qkt(pB0, pB1, (bf16*)((char*)K_lds + SHM_K), qr, r32, hi);
  finishSM(pA0, pA1, alA, l_reg, pa0, pa1, pa2, pa3); SBAR();
  pv_d0(o, vb0, pa0, pa1, pa2, pa3); partialSM(pB0, pB1, m_reg, mnB, alB);
  __syncthreads(); RESC(alB);
  finishSM(pB0, pB1, alB, l_reg, pa0, pa1, pa2, pa3); SBAR();
  pv_d0(o, vb0 + (int)SHM_V, pa0, pa1, pa2, pa3);
  if (hi == 0) li_l[r32] = l_reg; asm volatile("s_waitcnt lgkmcnt(0)" ::: "memory");
  float rli[16];
#pragma unroll
  for (int r = 0; r < 16; ++r) rli[r] = __builtin_amdgcn_rcpf(li_l[crow(r, hi)]);
  __syncthreads();
  unsigned short* stg = (unsigned short*)lds + wid * (QBLK * D);
#pragma unroll
  for (int r = 0; r < 16; ++r) { const int orow = crow(r, hi);
#pragma unroll
    for (int d0 = 0; d0 < 4; ++d0) stg[orow * D + d0 * 32 + r32] = (unsigned short)(cvtpk(o[d0][r] * rli[r], 0.f) & 0xffffu); }
  asm volatile("s_waitcnt lgkmcnt(0)" ::: "memory");
  bf16* Ow = Ob + (long)(wid * QBLK) * LDO;
#pragma unroll
  for (int i = 0; i < 8; ++i) { const int row = i * 4 + (lane >> 4), ch = lane & 15; const u32x4 v = *(const u32x4*)(stg + row * D + ch * 8); *(u32x4*)(Ow + (long)row * LDO + ch * 8) = v; }
  __syncthreads();
#undef SLOAD
#undef SWRITE
#undef SWAIT
#undef RESC
}


template <int D0> __device__ __forceinline__ void pv_rd(s16x4 (&l)[4], s16x4 (&h)[4], int vb) {
  l[0] = tr_read<v_rd_off(D0, 0, 0)>(vb); h[0] = tr_read<v_rd_off(D0, 0, 1)>(vb); l[1] = tr_read<v_rd_off(D0, 1, 0)>(vb); h[1] = tr_read<v_rd_off(D0, 1, 1)>(vb);
  l[2] = tr_read<v_rd_off(D0, 2, 0)>(vb); h[2] = tr_read<v_rd_off(D0, 2, 1)>(vb); l[3] = tr_read<v_rd_off(D0, 3, 0)>(vb); h[3] = tr_read<v_rd_off(D0, 3, 1)>(vb);
}
__device__ __forceinline__ void pv_mm(f32x16& od, const s16x4 (&l)[4], const s16x4 (&h)[4], bf16x8 pa0, bf16x8 pa1, bf16x8 pa2, bf16x8 pa3) {
#define PK(L, H) (bf16x8){L[0], L[1], L[2], L[3], H[0], H[1], H[2], H[3]}
  od = __builtin_amdgcn_mfma_f32_32x32x16_bf16(pa0, PK(l[0], h[0]), od, 0, 0, 0);
  od = __builtin_amdgcn_mfma_f32_32x32x16_bf16(pa1, PK(l[1], h[1]), od, 0, 0, 0);
  od = __builtin_amdgcn_mfma_f32_32x32x16_bf16(pa2, PK(l[2], h[2]), od, 0, 0, 0);
  od = __builtin_amdgcn_mfma_f32_32x32x16_bf16(pa3, PK(l[3], h[3]), od, 0, 0, 0);
#undef PK
}
__device__ __forceinline__ void pv_pipe(f32x16* o, int vb, s16x4 (&la)[4], s16x4 (&ha)[4], bf16x8 pa0, bf16x8 pa1, bf16x8 pa2, bf16x8 pa3) {
  s16x4 lb[4], hb[4];
  pv_rd<1>(lb, hb, vb); asm volatile("s_waitcnt lgkmcnt(8)" ::: "memory"); SBAR(); pv_mm(o[0], la, ha, pa0, pa1, pa2, pa3); SBAR();
  pv_rd<2>(la, ha, vb); asm volatile("s_waitcnt lgkmcnt(8)" ::: "memory"); SBAR(); pv_mm(o[1], lb, hb, pa0, pa1, pa2, pa3); SBAR();
  pv_rd<3>(lb, hb, vb); asm volatile("s_waitcnt lgkmcnt(8)" ::: "memory"); SBAR(); pv_mm(o[2], la, ha, pa0, pa1, pa2, pa3); SBAR();
  asm volatile("s_waitcnt lgkmcnt(0)" ::: "memory"); SBAR(); pv_mm(o[3], lb, hb, pa0, pa1, pa2, pa3); SBAR();
}

template <int OFF> __device__ __forceinline__ bf16x8 k_read(int addr) { bf16x8 r; asm volatile("ds_read_b128 %0, %1 offset:%2" : "=&v"(r) : "v"(addr), "i"(OFF) : "memory"); return r; }
template <int G> __device__ __forceinline__ void qk_rd(bf16x8 (&f)[4], const int (&ka)[4]) {
  f[0] = k_read<(G >> 1) * 128>(ka[(2 * G) & 3]);     f[1] = k_read<(G >> 1) * 128 + 8192>(ka[(2 * G) & 3]);
  f[2] = k_read<(G >> 1) * 128>(ka[(2 * G + 1) & 3]); f[3] = k_read<(G >> 1) * 128 + 8192>(ka[(2 * G + 1) & 3]);
}
template <int G> __device__ __forceinline__ void qk_mm(f32x16& p0, f32x16& p1, const bf16x8 (&f)[4], const bf16x8* qr) {
  if constexpr (G == 0) { const f32x16 z = {}; p0 = __builtin_amdgcn_mfma_f32_32x32x16_bf16(f[0], qr[0], z, 0, 0, 0); p1 = __builtin_amdgcn_mfma_f32_32x32x16_bf16(f[1], qr[0], z, 0, 0, 0); }
  else { p0 = __builtin_amdgcn_mfma_f32_32x32x16_bf16(f[0], qr[2 * G], p0, 0, 0, 0); p1 = __builtin_amdgcn_mfma_f32_32x32x16_bf16(f[1], qr[2 * G], p1, 0, 0, 0); }
  p0 = __builtin_amdgcn_mfma_f32_32x32x16_bf16(f[2], qr[2 * G + 1], p0, 0, 0, 0); p1 = __builtin_amdgcn_mfma_f32_32x32x16_bf16(f[3], qr[2 * G + 1], p1, 0, 0, 0);
}
__device__ __forceinline__ void qkt_pipe(f32x16& p0, f32x16& p1, const int (&kb)[4], int kslot, const bf16x8* qr) {
  int ka[4]; ka[0] = kb[0] + kslot; ka[1] = kb[1] + kslot; ka[2] = kb[2] + kslot; ka[3] = kb[3] + kslot;
  bf16x8 fa[4], fb[4];
  qk_rd<0>(fa, ka); qk_rd<1>(fb, ka); asm volatile("s_waitcnt lgkmcnt(4)" ::: "memory"); SBAR(); qk_mm<0>(p0, p1, fa, qr); SBAR();
  qk_rd<2>(fa, ka); asm volatile("s_waitcnt lgkmcnt(4)" ::: "memory"); SBAR(); qk_mm<1>(p0, p1, fb, qr); SBAR();
  qk_rd<3>(fb, ka); asm volatile("s_waitcnt lgkmcnt(4)" ::: "memory"); SBAR(); qk_mm<2>(p0, p1, fa, qr); SBAR();
  asm volatile("s_waitcnt lgkmcnt(0)" ::: "memory"); SBAR(); qk_mm<3>(p0, p1, fb, qr); SBAR();
}
constexpr size_t SHM_ATTN2 = 3 * SHM_V + 3 * SHM_K + NW * 64 * 4;
__device__ __forceinline__ void softmaxY(f32x16& p0, f32x16& p1, float& m_reg, float& l_reg, float& alpha, bf16x8& pa0, bf16x8& pa1, bf16x8& pa2, bf16x8& pa3) {
  float mn; partialSM(p0, p1, m_reg, mn, alpha); finishSM(p0, p1, alpha, l_reg, pa0, pa1, pa2, pa3);
}
__device__ __forceinline__ void attn_unit2(const bf16* Qb, const bf16* __restrict__ K0, const bf16* __restrict__ V0, int n0, const bf16* __restrict__ K1, const bf16* __restrict__ V1, int ntot, bf16* Ob, char* lds) {
  int tid = threadIdx.x; asm volatile("" : "+v"(tid));
  const int wid = tid >> 6, lane = tid & 63, r32 = lane & 31, hi = lane >> 5, grp = __builtin_amdgcn_readfirstlane(wid >> 2);
  bf16* V_lds = (bf16*)lds; bf16* K_lds = (bf16*)(lds + 3 * SHM_V);
  float* ws = (float*)(lds + 3 * SHM_V + 3 * SHM_K) + wid * 64; float* li_l = ws; float* al_l = ws + 32;
  float m_reg = -1e30f, l_reg = 0; f32x16 o[4] = {}; bf16x8 qr[8];
  const bf16* Qw = Qb + (long)(wid * QBLK + r32) * LDQ + hi * 8;
#pragma unroll
  for (int d0 = 0; d0 < 8; ++d0) qr[d0] = *reinterpret_cast<const bf16x8*>(Qw + d0 * 16);
  const int sr = tid >> 4, sc = (tid & 15) * 8, vst0 = v_st(sr, sc), vst1 = v_st(32 + sr, sc);
  const int vb0 = (int)(uintptr_t)V_lds + v_rd_base(lane);
  const unsigned soff = (unsigned)(sr * LDK + sc) * 2u;
  bf16x8 vs0, vs1, ks0, ks1;
  int kb[4];
#pragma unroll
  for (int d = 0; d < 4; ++d) kb[d] = (int)(uintptr_t)K_lds + KSWZ(r32, d * 32 + hi * 16);
#define SLOAD2(k0) do { const int k0_ = (k0); const char* kp_ = (const char*)(k0_ < n0 ? K0 + (long)k0_ * LDK : K1 + (long)(k0_ - n0) * LDK); \
    const char* vp_ = (const char*)(k0_ < n0 ? V0 + (long)k0_ * LDK : V1 + (long)(k0_ - n0) * LDK); \
    vs0 = *reinterpret_cast<const bf16x8*>(vp_ + soff); vs1 = *reinterpret_cast<const bf16x8*>(vp_ + 32 * LDK * 2 + soff); \
    ks0 = *reinterpret_cast<const bf16x8*>(kp_ + soff); ks1 = *reinterpret_cast<const bf16x8*>(kp_ + 32 * LDK * 2 + soff); } while (0)
#define SWRITE2(slot) do { const int so_ = (slot) * (int)SHM_V; const int kc = sc * 2; \
    *(bf16x8*)((char*)V_lds + so_ + vst0) = vs0; *(bf16x8*)((char*)V_lds + so_ + vst1) = vs1; \
    *(bf16x8*)((char*)K_lds + so_ + KSWZ(sr, kc)) = ks0; *(bf16x8*)((char*)K_lds + so_ + KSWZ(32 + sr, kc)) = ks1; } while (0)
#define XBAR() do { asm volatile("s_waitcnt lgkmcnt(0)" ::: "memory"); __builtin_amdgcn_s_barrier(); asm volatile("" ::: "memory"); SBAR(); } while (0)
#define RESC2(a) do { if (__any((a) < 1.f)) { if (hi == 0) al_l[r32] = (a); asm volatile("s_waitcnt lgkmcnt(0)" ::: "memory"); \
    for (int d = 0; d < 4; ++d) for (int r = 0; r < 16; ++r) o[d][r] *= al_l[crow(r, hi)]; } } while (0)
  const int NT = ntot / KVBLK;
  f32x16 p0, p1; float alpha; bf16x8 pa0, pa1, pa2, pa3;
  SLOAD2(0); asm volatile("s_waitcnt vmcnt(0)" ::: "memory"); SWRITE2(0); SLOAD2(KVBLK);
  XBAR();
  if (grp == 1) XBAR();
  SBAR(); qkt_pipe(p0, p1, kb, 0, qr);
  asm volatile("s_waitcnt vmcnt(0)" ::: "memory"); SWRITE2(1); if (2 < NT) SLOAD2(2 * KVBLK);
  XBAR();
  int sj = 0, sj1 = 1, sj2 = 2;
  for (int j = 0; j < NT; ++j) {
    softmaxY(p0, p1, m_reg, l_reg, alpha, pa0, pa1, pa2, pa3); RESC2(alpha);
    XBAR();
    { s16x4 la[4], ha[4]; const int vb = vb0 + sj * (int)SHM_V; pv_rd<0>(la, ha, vb);
      if (j + 1 < NT) qkt_pipe(p0, p1, kb, sj1 * (int)SHM_K, qr);
      pv_pipe(o, vb, la, ha, pa0, pa1, pa2, pa3); }
    if (j + 2 < NT) { asm volatile("s_waitcnt vmcnt(0)" ::: "memory"); SWRITE2(sj2); if (j + 3 < NT) SLOAD2((j + 3) * KVBLK); }
    XBAR();
    { const int t_ = sj; sj = sj1; sj1 = sj2; sj2 = t_; }
  }
  if (grp == 0) XBAR();
  if (hi == 0) li_l[r32] = l_reg; asm volatile("s_waitcnt lgkmcnt(0)" ::: "memory");
  float rli[16];
#pragma unroll
  for (int r = 0; r < 16; ++r) rli[r] = __builtin_amdgcn_rcpf(li_l[crow(r, hi)]);
  unsigned short* stg = (unsigned short*)lds + wid * (QBLK * D);
#pragma unroll
  for (int r = 0; r < 16; ++r) { const int orow = crow(r, hi);
#pragma unroll
    for (int d0 = 0; d0 < 4; ++d0) stg[orow * D + d0 * 32 + r32] = (unsigned short)(cvtpk(o[d0][r] * rli[r], 0.f) & 0xffffu); }
  asm volatile("s_waitcnt lgkmcnt(0)" ::: "memory");
  bf16* Ow = Ob + (long)(wid * QBLK) * LDO;
#pragma unroll
  for (int i = 0; i < 8; ++i) { const int row = i * 4 + (lane >> 4), ch = lane & 15; const u32x4 v = *(const u32x4*)(stg + row * D + ch * 8); *(u32x4*)(Ow + (long)row * LDO + ch * 8) = v; }
  XBAR();
#undef SLOAD2
#undef SWRITE2
#undef XBAR
#undef RESC2
}
#undef KSWZ
#undef SBAR
}
#define RLX_AGENT __ATOMIC_RELAXED, __HIP_MEMORY_SCOPE_AGENT
#define LDS_WAIT() asm volatile("s_waitcnt lgkmcnt(0)" ::: "memory")
#define VM_WAIT() asm volatile("s_waitcnt vmcnt(0)" ::: "memory")
__device__ __forceinline__ unsigned long long rt() { return __builtin_amdgcn_s_memrealtime(); }
#define XB_TMO      128
#define XB_XCNT(j)  (256  + 64 * (j))
#define XB_XSUB(j)  (1280 + 64 * (j))
#define XB_XGEN(j)  (2304 + 64 * (j))
#define XB_TOP      3328
#define XB_TOPGEN   3392
#define XCD_BAR_WORDS 3456
#define XB_SPIN_CAP (1u << 18)

__device__ __forceinline__ unsigned xb_ld(unsigned* p)              { return __hip_atomic_load(p, __ATOMIC_RELAXED, __HIP_MEMORY_SCOPE_AGENT); }
__device__ __forceinline__ unsigned xb_add(unsigned* p, unsigned v) { return __hip_atomic_fetch_add(p, v, __ATOMIC_RELAXED, __HIP_MEMORY_SCOPE_AGENT); }
__device__ __forceinline__ unsigned xb_xcc_id() { return (unsigned)__builtin_amdgcn_s_getreg((3 << 11) | 20) & 0xFu; }
#define XB_SPIN(cond, bar) do { unsigned _sp = 0; while (cond) { __builtin_amdgcn_s_sleep(1); \
    if ((++_sp & 255u) == 0u) { if (xb_ld(&(bar)[XB_TMO])) break; if (_sp > XB_SPIN_CAP) { atomicAdd(&(bar)[XB_TMO], 1u); break; } } } } while (0)

struct XcdBarrier {
    unsigned* bar; unsigned x;
    volatile LAS unsigned* st;
};

__device__ __forceinline__ XcdBarrier xcd_barrier_post(unsigned* bar, volatile LAS unsigned* st) {
    XcdBarrier b; b.bar = bar; b.x = xb_xcc_id(); b.st = st;
    if (threadIdx.x == 0) (void)xb_add(&bar[XB_XCNT(b.x)], 1u);
    return b;
}
__device__ __forceinline__ void xcd_barrier_complete(unsigned* bar, unsigned x, unsigned& nloc, unsigned& nx) {
    const unsigned G = gridDim.x * gridDim.y * gridDim.z;
    unsigned sum, cnt, mine, sp = 0u;
    for (;;) {
        sum = 0u; cnt = 0u; mine = 0u;
#pragma unroll
        for (unsigned j = 0; j < 16; ++j) { const unsigned c = xb_ld(&bar[XB_XCNT(j)]); sum += c; cnt += (c > 0u) ? 1u : 0u; mine = (j == x) ? c : mine; }
        if (sum == G) break;
        __builtin_amdgcn_s_sleep(1);
        if ((++sp & 255u) == 0u) { if (xb_ld(&bar[XB_TMO])) break; if (sp > XB_SPIN_CAP) { atomicAdd(&bar[XB_TMO], 1u); break; } }
    }
    nloc = mine > 0u ? mine : 1u; nx = cnt > 0u ? cnt : 1u;
}

__device__ __forceinline__ void xcd_barrier(const XcdBarrier& b) {
    asm volatile("s_waitcnt vmcnt(0)" ::: "memory");
    __syncthreads();
    if (threadIdx.x == 0) {
        unsigned* bar = b.bar;
        __builtin_amdgcn_s_waitcnt(0);
        unsigned nloc = b.st[0], nx = b.st[1];
        if (nloc == 0u) { xcd_barrier_complete(bar, b.x, nloc, nx); b.st[0] = nloc; b.st[1] = nx; }
        const unsigned old = xb_add(&bar[XB_XSUB(b.x)], 1u);
        const unsigned gen = old / nloc;
        if (old + 1u == (gen + 1u) * nloc) {
            __builtin_amdgcn_fence(__ATOMIC_RELEASE, "agent");
            asm volatile("s_waitcnt vmcnt(0)" ::: "memory");
            const unsigned og = xb_add(&bar[XB_TOP], 1u);
            const unsigned tg = og / nx;
            if (og + 1u == (tg + 1u) * nx) xb_add(&bar[XB_TOPGEN], 1u);
            else XB_SPIN(xb_ld(&bar[XB_TOPGEN]) == tg, bar);
            __builtin_amdgcn_fence(__ATOMIC_ACQUIRE, "agent");
            xb_add(&bar[XB_XGEN(b.x)], 1u);
            asm volatile("s_waitcnt vmcnt(0)" ::: "memory");
        } else {
            XB_SPIN(xb_ld(&bar[XB_XGEN(b.x)]) == gen, bar);
            __builtin_amdgcn_fence(__ATOMIC_ACQUIRE, "agent");
            asm volatile("s_waitcnt vmcnt(0)" ::: "memory");
        }
    }
    __syncthreads();
}
constexpr int RING_BYTES = 131072, XCH_OFF = RING_BYTES, XCH_BYTES = 8192, MISC_OFF = XCH_OFF + XCH_BYTES, LDS_BYTES = 147456;
constexpr int CW_BAR = 4096;
constexpr int PH_PREP = 0, PH_ADA = 1, PH_L0 = 2, PH_PER_LAYER = 8, PH_FINAL = PH_L0 + DEPTH * PH_PER_LAYER, PH_COUNT = PH_FINAL + 1;

__device__ __forceinline__ void ph_attention(unsigned char* ws, int layer, int vcu, char* lds) {
    bf16* QO = (bf16*)(ws + WS_Q); const bf16* KB = (const bf16*)(ws + WS_K); const bf16* VB = (const bf16*)(ws + WS_V);
    const bf16* KC = (const bf16*)(ws + WS_KC); const bf16* VC = (const bf16*)(ws + WS_VC);
    const int xcd = vcu >> 5, j = vcu & 31;
    for (int i = 0; i < 6; ++i) {
        int b, head, kvh, n0, ntot; size_t row0, qrow; const bf16 *k1, *v1;
        if (i < 4) { const int grp = xcd * 4 + i; b = grp >> 2; kvh = grp & 3; head = kvh * 4 + (j >> 3); row0 = (size_t)NCTX + (size_t)b * 2048; qrow = row0 + (size_t)(j & 7) * 256; n0 = 2048; ntot = 2304;
                     k1 = KC + (size_t)((layer * 8 + b) * 256) * DKV + kvh * HD; v1 = VC + (size_t)((layer * 8 + b) * 256) * DKV + kvh * HD; }
        else { const int uc = vcu * 2 + (i - 4); b = uc >> 4; head = uc & 15; kvh = head >> 2; row0 = (size_t)b * 256; qrow = row0; n0 = 256; ntot = 256; k1 = KB; v1 = VB; }
        bf16* q = QO + qrow * DM + head * HD;
        att::attn_unit2(q, KB + row0 * DKV + kvh * HD, VB + row0 * DKV + kvh * HD, n0, k1, v1, ntot, q, lds);
    }
}

struct MkArgs { Params p; int ph_lo, ph_hi; };
__global__ void __launch_bounds__(512, 2) mk_fwd(MkArgs a) {
    extern __shared__ __attribute__((aligned(16))) unsigned char lds_raw[];
    LAS unsigned char* lds = (LAS unsigned char*)lds_raw;
    const Params& p = a.p;
    const int wave = __builtin_amdgcn_readfirstlane((int)threadIdx.x >> 6);
    const int G = gridDim.x, bx = blockIdx.x, vcu = (bx % 8) * (G / 8) + bx / 8;
    if (G != 256) return;
    volatile LAS unsigned* MISC = (volatile LAS unsigned*)(lds + MISC_OFF);
    if (threadIdx.x < 32) MISC[threadIdx.x] = 0u;
    __syncthreads();
    XcdBarrier bar = xcd_barrier_post((unsigned*)(p.ws + WS_CTL) + CW_BAR, MISC + 8);
    const int lo = a.ph_lo, hi = a.ph_hi;
#define PHASE_VARS int tid_l = threadIdx.x, vcu_l = vcu; asm volatile("" : "+v"(tid_l), "+s"(vcu_l)); const int lane = tid_l & 63, gt = vcu_l * 512 + tid_l, gw = vcu_l * 8 + wave, ngw = G * 8, ngt = G * 512; \
                   (void)lane; (void)gt; (void)gw; (void)ngw; (void)ngt; \
                   const __attribute__((address_space(4))) MkArgs* ap_ = (const __attribute__((address_space(4))) MkArgs*)__builtin_amdgcn_kernarg_segment_ptr(); asm volatile("" : "+s"(ap_)); \
                   Params q; q.x_prompt = ap_->p.x_prompt; q.x_sample = ap_->p.x_sample; q.cache_k = ap_->p.cache_k; q.cache_v = ap_->p.cache_v; q.c = ap_->p.c; q.c_ctx = ap_->p.c_ctx; q.w_ada = ap_->p.w_ada; q.b_ada = ap_->p.b_ada; q.norm1 = ap_->p.norm1; q.w_in = ap_->p.w_in; q.q_gain = ap_->p.q_gain; q.k_gain = ap_->p.k_gain; q.conv_w = ap_->p.conv_w; q.conv_b = ap_->p.conv_b; q.w_a = ap_->p.w_a; q.w_b = ap_->p.w_b; q.w_o = ap_->p.w_o; q.norm2 = ap_->p.norm2; q.w_gate = ap_->p.w_gate; q.w_up = ap_->p.w_up; q.w_down = ap_->p.w_down; q.norm_f = ap_->p.norm_f; q.out = ap_->p.out; q.ws = ap_->p.ws; unsigned char* ws = q.ws; float* outp = q.out
#define IN(k) (lo <= (k) && (k) < hi)
#define SEAM(k) do { if ((k) + 1 < hi) xcd_barrier(bar); } while (0)

    if (IN(PH_PREP)) {
        PHASE_VARS;
        ph_ada_partials(q, (LAS float*)lds, gw, ngw, lane, tid_l, 512);
        ph_misc_prep(q, gt, ngt);
        __syncthreads();
        ph_weights(q, (LAS float*)lds + wave * (64 * 33), gw, ngw, lane);
        SEAM(PH_PREP);
    }
    if (IN(PH_ADA)) { PHASE_VARS; ph_ada_reduce(q, gt, ngt); SEAM(PH_ADA); }

    for (int l = 0; l < DEPTH; ++l) {
        const int pb = PH_L0 + l * PH_PER_LAYER;
        if (IN(pb + 0)) { PHASE_VARS; ph_norm(q, l, 0, gw, ngw, lane); SEAM(pb + 0); }
        if (IN(pb + 1)) {
            PHASE_VARS; const unsigned char* wl = ws + WS_W + (size_t)l * W_LAYER;
            pg8::Gemm g{(const bf16*)(ws + WS_HB), (const bf16*)(wl + W_IN), MTOK, NIN, DM}; pg8::StaticOrder S; S.init(MTOK, NIN, G, bx);
            pg8::EpiIn E{ws, outp, q.q_gain + l * HD, q.k_gain + l * HD, (LAS float*)(lds + XCH_OFF), l};
            if (wave < 4) pg8::gemm_phase<pg8::EpiIn, pg8::StaticOrder, true, true, 0>(lds, g, S, E); else pg8::gemm_phase<pg8::EpiIn, pg8::StaticOrder, true, true, 1>(lds, g, S, E);
            SEAM(pb + 1);
        }
        if (IN(pb + 2)) { PHASE_VARS; ph_conv(q, l, gt, ngt); ph_attention(ws, l, vcu, (char*)lds_raw); SEAM(pb + 2); }
        if (IN(pb + 3)) {
            PHASE_VARS; const unsigned char* wl = ws + WS_W + (size_t)l * W_LAYER;
            pg8::Gemm2 g{(const bf16*)(ws + WS_CVB), (const bf16*)(wl + W_A), (const bf16*)(ws + WS_Q), (const bf16*)(wl + W_B), DCONV / 64, DM / 64, DM}; pg8::StaticOrder S; S.init(MTOK, DM, G, bx);
            pg8::MidR Mm{(const bf16*)(ws + WS_R)}; pg8::EpiB2 E{(const bf16*)(ws + WS_SB), (bf16*)(ws + WS_HB)};
            if (wave < 4) pg8::gemm_phase_ab<pg8::MidR, pg8::EpiB2, pg8::StaticOrder, true, true, 0>(lds, g, S, Mm, E); else pg8::gemm_phase_ab<pg8::MidR, pg8::EpiB2, pg8::StaticOrder, true, true, 1>(lds, g, S, Mm, E);
            SEAM(pb + 3);
        }
        if (IN(pb + 4)) {
            PHASE_VARS; const unsigned char* wl = ws + WS_W + (size_t)l * W_LAYER;
            pg8::Gemm g{(const bf16*)(ws + WS_HB), (const bf16*)(wl + W_O), MTOK, DM, DM}; pg8::StaticOrder S; S.init(MTOK, DM, G, bx);
            pg8::EpiRes E{(bf16*)(ws + WS_X), (const float*)(ws + WS_MODS) + (size_t)l * NMOD * 6 * DM, 2, l == 0 ? q.x_prompt : nullptr, l == 0 ? q.x_sample : nullptr};
            if (wave < 4) pg8::gemm_phase<pg8::EpiRes, pg8::StaticOrder, true, true, 0>(lds, g, S, E); else pg8::gemm_phase<pg8::EpiRes, pg8::StaticOrder, true, true, 1>(lds, g, S, E);
            SEAM(pb + 4);
        }
        if (IN(pb + 5)) { PHASE_VARS; ph_norm(q, l, 1, gw, ngw, lane); SEAM(pb + 5); }
        if (IN(pb + 6)) {
            PHASE_VARS; const unsigned char* wl = ws + WS_W + (size_t)l * W_LAYER;
            pg8::Gemm g{(const bf16*)(ws + WS_HB), (const bf16*)(wl + W_GU), MTOK, NGU, DM}; pg8::StaticOrder S; S.init(MTOK, NGU, G, bx);
            pg8::EpiGU E{(bf16*)(ws + WS_ACT)};
            if (wave < 4) pg8::gemm_phase<pg8::EpiGU, pg8::StaticOrder, true, true, 0>(lds, g, S, E); else pg8::gemm_phase<pg8::EpiGU, pg8::StaticOrder, true, true, 1>(lds, g, S, E);
            if (l + 1 < DEPTH && bx >= 128) ph_weights_tail(q, (LAS float*)lds + wave * (64 * 33), l + 1, (bx - 128) * 8 + wave, 1024, lane);
            SEAM(pb + 6);
        }
        if (IN(pb + 7)) {
            PHASE_VARS; const unsigned char* wl = ws + WS_W + (size_t)l * W_LAYER;
            pg8::Gemm g{(const bf16*)(ws + WS_ACT), (const bf16*)(wl + W_D), MTOK, DM, DFF}; pg8::StaticOrder S; S.init(MTOK, DM, G, bx);
            pg8::EpiRes E{(bf16*)(ws + WS_X), (const float*)(ws + WS_MODS) + (size_t)l * NMOD * 6 * DM, 5, nullptr, nullptr};
            if (wave < 4) pg8::gemm_phase<pg8::EpiRes, pg8::StaticOrder, true, true, 0>(lds, g, S, E); else pg8::gemm_phase<pg8::EpiRes, pg8::StaticOrder, true, true, 1>(lds, g, S, E);
            SEAM(pb + 7);
        }
    }
    if (IN(PH_FINAL)) { PHASE_VARS; ph_final_norm(q, gw, ngw, lane); }
#undef IN
#undef SEAM
#undef PHASE_VARS
}
static Params make_params(void* const* d_in, void* d_out, void* d_ws) {
    Params p{};
    p.x_prompt = (const float*)d_in[0]; p.x_sample = (const float*)d_in[1]; p.cache_k = (const float*)d_in[2]; p.cache_v = (const float*)d_in[3];
    p.c = (const float*)d_in[4]; p.c_ctx = (const float*)d_in[5]; p.w_ada = (const float*)d_in[6]; p.b_ada = (const float*)d_in[7]; p.norm1 = (const float*)d_in[8];
    p.w_in = (const float*)d_in[9]; p.q_gain = (const float*)d_in[10]; p.k_gain = (const float*)d_in[11]; p.conv_w = (const float*)d_in[12]; p.conv_b = (const float*)d_in[13];
    p.w_a = (const float*)d_in[14]; p.w_b = (const float*)d_in[15]; p.w_o = (const float*)d_in[16]; p.norm2 = (const float*)d_in[17];
    p.w_gate = (const float*)d_in[18]; p.w_up = (const float*)d_in[19]; p.w_down = (const float*)d_in[20]; p.norm_f = (const float*)d_in[21];
    p.out = (float*)d_out; p.ws = (unsigned char*)d_ws; return p;
}
static void mk_launch(const Params& p, int lo, int hi, int grid, hipStream_t stream) {
    (void)hipMemsetAsync(p.ws + WS_CTL, 0, CTL_ZERO_BYTES, stream);
    MkArgs a{}; a.p = p; a.ph_lo = lo; a.ph_hi = hi;
    hipLaunchKernelGGL(mk_fwd, dim3(grid), dim3(512), LDS_BYTES, stream, a);
    const hipError_t le = hipPeekAtLastError();
    if (le != hipSuccess) fprintf(stderr, "kernel_launch: mk_fwd launch failed: %s (grid %d)\n", hipGetErrorName(le), grid);
}
extern "C" void kernel_launch(void* const* d_in, const int* in_sizes, int n_in, void* d_out, int out_size, void* d_ws, size_t ws_size, hipStream_t stream) {
    static int grid = 0;
    if (grid == 0) {
        if (n_in != 22 || out_size != 83886080 || ws_size < WS_END) { fprintf(stderr, "kernel_launch: unexpected shapes: n_in %d out %d ws %zu (need %zu)\n", n_in, out_size, ws_size, (size_t)WS_END); grid = -1; return; }
        int dev = 0, cus = 0, per_cu = 0;
        if (hipGetDevice(&dev) != hipSuccess || hipDeviceGetAttribute(&cus, hipDeviceAttributeMultiprocessorCount, dev) != hipSuccess) { grid = -1; return; }
        if (hipFuncSetAttribute((const void*)mk_fwd, hipFuncAttributeMaxDynamicSharedMemorySize, LDS_BYTES) != hipSuccess) { fprintf(stderr, "kernel_launch: hipFuncSetAttribute failed\n"); grid = -1; return; }
        if (hipOccupancyMaxActiveBlocksPerMultiprocessor(&per_cu, (const void*)mk_fwd, 512, LDS_BYTES) != hipSuccess || per_cu < 1) fprintf(stderr, "kernel_launch: occupancy query says %d\n", per_cu);
        (void)hipGetLastError();
        grid = cus;
    }
    if (grid < 0) return;
    const Params p = make_params(d_in, d_out, d_ws);
    mk_launch(p, 0, PH_COUNT, grid, stream);
}
```

```cpp
#include <hip/hip_runtime.h>
#include <cstdio>
#include <cstdint>
namespace pg8 {
#define PG8_LAS __attribute__((address_space(3)))
typedef unsigned short bf16_t;
typedef short bf16x8 __attribute__((ext_vector_type(8)));
typedef float f32x4 __attribute__((ext_vector_type(4)));
typedef unsigned u32x4 __attribute__((ext_vector_type(4)));
constexpr int BM = 256, BK = 64, HALF = 128, HTB = HALF * BK * 2  , STAGE_BYTES = 8 * HTB, NXCD = 8, WGM = 8;

__host__ __device__ __forceinline__ int lds_byte(int r, int c) { const int st = (r >> 4) * 2 + (c >> 5), rr = r & 15, cc = c & 31, ob = rr * 64 + cc * 2; return st * 1024 + (ob ^ (((ob >> 9) & 1) << 5)); }
__host__ __device__ __forceinline__ void stage_rc(int b, int& R, int& C) { const int st = b / 1024, sb = b % 1024, swz = sb ^ (((sb >> 9) & 1) << 5); R = (st >> 1) * 16 + swz / 64; C = (st & 1) * 32 + (swz % 64) / 2; }
__host__ __device__ __forceinline__ int perm32(int rho) { const int n = rho >> 4, i = rho & 15; return 8 * (i >> 2) + 4 * n + (i & 3); }

struct Unit { int pm, pn; };
struct Gemm { const bf16_t* A; const bf16_t* Bt; int M, N, K; };

struct StaticOrder {
    int nM, nN, nwg, G, c;
    __host__ __device__ void init(int M, int N, int G_, int c_) { nM = M / BM; nN = N / BM; nwg = nM * nN; G = G_; c = c_; }
    __host__ __device__ bool next(int i, Unit& u) const {
        const long L = (long)i * G + c; if (L >= nwg) return false;
        int wgid = (int)L; { const int q = nwg / NXCD, r = nwg % NXCD, xcd = wgid % NXCD, off = wgid / NXCD; wgid = (xcd < r ? xcd * (q + 1) : r * (q + 1) + (xcd - r) * q) + off; }
        const int nig = WGM * nN, gid = wgid / nig, fm = gid * WGM, gsz = (nM - fm) < WGM ? (nM - fm) : WGM;
        u.pm = fm + ((wgid % nig) % gsz); u.pn = (wgid % nig) / gsz; return true;
    }
    __device__ __forceinline__ void a_ready(const Unit&) const {}
    __device__ __forceinline__ void done(const Unit&) const {}
};

__device__ __forceinline__ unsigned cvt_pk_bf16(float lo, float hi) { unsigned r; asm volatile("v_cvt_pk_bf16_f32 %0, %1, %2" : "=v"(r) : "v"(lo), "v"(hi)); return r; }
template <class Epi, class Sched, bool ALIGN_EPI = false, bool SP2 = false, int WRSEL = 0>
__device__ __forceinline__ void gemm_phase(PG8_LAS unsigned char* lds, const Gemm g, const Sched& S, const Epi& E) {
    int tid = threadIdx.x; asm volatile("" : "+v"(tid));
    const int wid = __builtin_amdgcn_readfirstlane(tid >> 6), lane = tid & 63, wc = wid & 3, fr = lane & 15, fq = lane >> 4; constexpr int wr = WRSEL;
    int K = g.K; asm volatile("" : "+s"(K));     const int nt = K / BK;
    unsigned voffA[2], voffB[2];
#pragma unroll
    for (int i = 0; i < 2; ++i) { int R, C; stage_rc(tid * 16 + i * 8192, R, C); const int Rb = Epi::PERM ? ((R & ~31) + perm32(R & 31)) : R;
        voffA[i] = (unsigned)(R * K + C) * 2u; voffB[i] = (unsigned)(Rb * K + C) * 2u; }
    const size_t kstep = (size_t)(BK * 2);
    const size_t hstep = (size_t)HALF * K * 2;
    const size_t tstep = 2 * hstep;
    const unsigned ldsw = (unsigned)wid * 1024u;
    const int aoff = lds_byte(wr * 64 + fr, fq * 8), boff = lds_byte(wc * 32 + fr, fq * 8);
#define PG8_SA(b, h) (((b) * 2 + (h)) * HTB)
#define PG8_SB(b, h) ((4 + (b) * 2 + (h)) * HTB)
#define PG8_STAGE(bufoff, gbase, voff) do { const char* gb_ = (const char*)(gbase); asm volatile("" : "+s"(gb_));     \
        _Pragma("unroll") for (int _i = 0; _i < 2; ++_i) \
        __builtin_amdgcn_global_load_lds((const unsigned*)(gb_ + (voff)[_i]), (PG8_LAS unsigned*)(lds + (bufoff) + ldsw + _i * 8192), 16, 0, 0); } while (0)
#define PG8_LDA(dst, b, h) do { _Pragma("unroll") for (int m = 0; m < 4; ++m) _Pragma("unroll") for (int k = 0; k < 2; ++k) dst[m][k] = *(const PG8_LAS bf16x8*)(lds + PG8_SA(b, h) + aoff + m * 2048 + k * 1024); } while (0)
#define PG8_LDB(dst, b, h) do { _Pragma("unroll") for (int n = 0; n < 2; ++n) _Pragma("unroll") for (int k = 0; k < 2; ++k) dst[n][k] = *(const PG8_LAS bf16x8*)(lds + PG8_SB(b, h) + boff + n * 2048 + k * 1024); } while (0)
#define PG8_MMA(ai, bj, At, Bt) do { __builtin_amdgcn_s_setprio(1); _Pragma("unroll") for (int m = 0; m < 4; ++m) _Pragma("unroll") for (int n = 0; n < 2; ++n) _Pragma("unroll") for (int k = 0; k < 2; ++k) \
        acc[ai][bj][m][n] = __builtin_amdgcn_mfma_f32_16x16x32_bf16(Bt[n][k], At[m][k], acc[ai][bj][m][n], 0, 0, 0); __builtin_amdgcn_s_setprio(0); } while (0)
#define PG8_MMA0(ai, bj, At, Bt) do { if (zc) { __builtin_amdgcn_s_setprio(1); const f32x4 z4_ = (f32x4){0.f, 0.f, 0.f, 0.f}; _Pragma("unroll") for (int m = 0; m < 4; ++m) _Pragma("unroll") for (int n = 0; n < 2; ++n) { \
        acc[ai][bj][m][n] = __builtin_amdgcn_mfma_f32_16x16x32_bf16(Bt[n][0], At[m][0], z4_, 0, 0, 0); acc[ai][bj][m][n] = __builtin_amdgcn_mfma_f32_16x16x32_bf16(Bt[n][1], At[m][1], acc[ai][bj][m][n], 0, 0, 0); } \
        __builtin_amdgcn_s_setprio(0); } else PG8_MMA(ai, bj, At, Bt); } while (0)
#define PG8_WAIT_V(n) asm volatile("s_waitcnt vmcnt(" #n ")" ::: "memory")
#define PG8_WAIT_L(n) asm volatile("s_waitcnt lgkmcnt(" #n ")" ::: "memory")
#define PG8_BAR __builtin_amdgcn_s_barrier()
#define PG8_SCHED __builtin_amdgcn_sched_barrier(0)
    Unit cur, nxt; int ui = 0;
    if (!S.next(0, cur)) return;
    f32x4 acc[2][2][4][2];
    bf16x8 At[4][2], B0[2][2], B1[2][2];
    const char* cA = (const char*)g.A + (size_t)cur.pm * tstep; const char* cB = (const char*)g.Bt + (size_t)cur.pn * tstep;
    S.a_ready(cur);
    if constexpr (SP2) {
        PG8_STAGE(PG8_SB(0, 0), cB, voffB); PG8_STAGE(PG8_SB(0, 1), cB + hstep, voffB); PG8_STAGE(PG8_SA(0, 0), cA, voffA); PG8_STAGE(PG8_SA(0, 1), cA + hstep, voffA);
        if (wr == 1) PG8_BAR;
        PG8_WAIT_V(2); PG8_BAR;
        PG8_STAGE(PG8_SB(1, 0), cB + kstep, voffB); PG8_STAGE(PG8_SB(1, 1), cB + hstep + kstep, voffB);
        PG8_WAIT_V(6); PG8_BAR;
    } else {
        PG8_STAGE(PG8_SB(0, 0), cB, voffB); PG8_STAGE(PG8_SA(0, 0), cA, voffA); PG8_STAGE(PG8_SB(0, 1), cB + hstep, voffB); PG8_STAGE(PG8_SA(0, 1), cA + hstep, voffA);
        if (wr == 1) PG8_BAR;
        PG8_WAIT_V(4); PG8_BAR;
        PG8_STAGE(PG8_SB(1, 0), cB + kstep, voffB); PG8_STAGE(PG8_SA(1, 0), cA + kstep, voffA); PG8_STAGE(PG8_SB(1, 1), cB + hstep + kstep, voffB);
        PG8_WAIT_V(6); PG8_BAR;
    }
    for (;;) {
        const bool has_next = S.next(ui + 1, nxt);
        const char* nA = has_next ? (const char*)g.A + (size_t)nxt.pm * tstep : cA; const char* nB = has_next ? (const char*)g.Bt + (size_t)nxt.pn * tstep : cB;
        for (int t = 0; t < nt; t += 2) {
            const bool last = (t == nt - 2); const bool zc = (t == 0);
            asm volatile("" : "+v"(voffA[0]), "+v"(voffA[1]), "+v"(voffB[0]), "+v"(voffB[1]));
            const char* a1 = cA + (size_t)(t + 1) * kstep;
            const char* a2 = last ? nA : cA + (size_t)(t + 2) * kstep; const char* b2 = last ? nB : cB + (size_t)(t + 2) * kstep;
            const char* a3 = a2 + kstep; const char* b3 = b2 + kstep;
            if (last && has_next) S.a_ready(nxt);
            if constexpr (SP2) {
            PG8_LDB(B0, 0, 0); PG8_LDB(B1, 0, 1); PG8_SCHED; PG8_LDA(At, 0, 0); PG8_STAGE(PG8_SA(1, 0), a1, voffA); PG8_STAGE(PG8_SA(1, 1), a1 + hstep, voffA);
            PG8_WAIT_V(8); PG8_WAIT_L(0); PG8_BAR; PG8_MMA0(0, 0, At, B0); PG8_MMA0(0, 1, At, B1); PG8_BAR; PG8_SCHED;
            PG8_LDA(At, 0, 1); PG8_STAGE(PG8_SB(0, 0), b2, voffB); PG8_STAGE(PG8_SB(0, 1), b2 + hstep, voffB);
            PG8_WAIT_V(6); PG8_WAIT_L(0); PG8_BAR; PG8_MMA0(1, 0, At, B0); PG8_MMA0(1, 1, At, B1); PG8_BAR; PG8_SCHED;
            PG8_LDB(B0, 1, 0); PG8_LDB(B1, 1, 1); PG8_SCHED; PG8_LDA(At, 1, 0); PG8_STAGE(PG8_SA(0, 0), a2, voffA); PG8_STAGE(PG8_SA(0, 1), a2 + hstep, voffA);
            PG8_WAIT_V(8); PG8_WAIT_L(0); PG8_BAR; PG8_MMA(0, 0, At, B0); PG8_MMA(0, 1, At, B1); PG8_BAR; PG8_SCHED;
            PG8_LDA(At, 1, 1); PG8_STAGE(PG8_SB(1, 0), b3, voffB); PG8_STAGE(PG8_SB(1, 1), b3 + hstep, voffB);
            PG8_WAIT_V(6); PG8_WAIT_L(0); PG8_BAR; PG8_MMA(1, 0, At, B0); PG8_MMA(1, 1, At, B1); PG8_BAR; PG8_SCHED;
            } else {
            PG8_LDB(B0, 0, 0); PG8_SCHED; PG8_LDA(At, 0, 0); PG8_STAGE(PG8_SA(1, 1), a1 + hstep, voffA);
            PG8_WAIT_L(8); PG8_BAR; PG8_WAIT_L(0); PG8_MMA(0, 0, At, B0); PG8_BAR; PG8_SCHED;
            PG8_LDB(B1, 0, 1); PG8_STAGE(PG8_SB(0, 0), b2, voffB);
            PG8_BAR; PG8_WAIT_L(0); PG8_MMA(0, 1, At, B1); PG8_BAR;
            PG8_LDA(At, 0, 1); PG8_STAGE(PG8_SA(0, 0), a2, voffA);
            PG8_BAR; PG8_WAIT_L(0); PG8_MMA(1, 0, At, B0); PG8_BAR; PG8_SCHED;
            PG8_STAGE(PG8_SB(0, 1), b2 + hstep, voffB);
            PG8_WAIT_V(6); PG8_BAR; PG8_MMA(1, 1, At, B1); PG8_BAR;
            PG8_LDB(B0, 1, 0); PG8_SCHED; PG8_LDA(At, 1, 0); PG8_STAGE(PG8_SA(0, 1), a2 + hstep, voffA);
            PG8_WAIT_L(8); PG8_BAR; PG8_WAIT_L(0); PG8_MMA(0, 0, At, B0); PG8_BAR; PG8_SCHED;
            PG8_LDB(B1, 1, 1); PG8_STAGE(PG8_SB(1, 0), b3, voffB);
            PG8_BAR; PG8_WAIT_L(0); PG8_MMA(0, 1, At, B1); PG8_BAR;
            PG8_LDA(At, 1, 1); PG8_STAGE(PG8_SA(1, 0), a3, voffA);
            PG8_BAR; PG8_WAIT_L(0); PG8_MMA(1, 0, At, B0); PG8_BAR; PG8_SCHED;
            PG8_STAGE(PG8_SB(1, 1), b3 + hstep, voffB);
            PG8_WAIT_V(6); PG8_BAR; PG8_MMA(1, 1, At, B1); PG8_BAR;
            }
        }
        if constexpr (ALIGN_EPI) { if (wr == 0) PG8_BAR; }
        if constexpr (!Epi::AFTER_DRAIN) { E(acc, cur, wr, wc, fr, fq); S.done(cur); }
        if (!has_next) break;
        cur = nxt; cA = nA; cB = nB; ++ui;
        if constexpr (ALIGN_EPI) { if (wr == 1) PG8_BAR; }
    }
    PG8_WAIT_V(0);
    if constexpr (!ALIGN_EPI) { if (wr == 0) PG8_BAR; }
    PG8_BAR;
    if constexpr (Epi::AFTER_DRAIN) { E.fused(acc, cur, wr, wc, fr, fq, lds, wid, lane); S.done(cur); }
#undef PG8_SA
#undef PG8_SB
#undef PG8_STAGE
#undef PG8_LDA
#undef PG8_LDB
#undef PG8_MMA
#undef PG8_MMA0
#undef PG8_WAIT_V
#undef PG8_WAIT_L
#undef PG8_BAR
#undef PG8_SCHED
}
struct Gemm2 { const bf16_t *A1, *B1, *A2, *B2; int nt1, nt2, K; };
template <class Mid, class Epi, class Sched, bool ALIGN_EPI = false, bool SP2 = false, int WRSEL = 0>
__device__ __forceinline__ void gemm_phase_ab(PG8_LAS unsigned char* lds, const Gemm2 g, const Sched& S, const Mid& Mm, const Epi& E) {
    int tid = threadIdx.x; asm volatile("" : "+v"(tid));
    const int wid = __builtin_amdgcn_readfirstlane(tid >> 6), lane = tid & 63, wc = wid & 3, fr = lane & 15, fq = lane >> 4; constexpr int wr = WRSEL;
    int K = g.K; asm volatile("" : "+s"(K));     int nt = g.nt1; int seg = 0;
    unsigned voffA[2], voffB[2];
#pragma unroll
    for (int i = 0; i < 2; ++i) { int R, C; stage_rc(tid * 16 + i * 8192, R, C); const int Rb = Epi::PERM ? ((R & ~31) + perm32(R & 31)) : R;
        voffA[i] = (unsigned)(R * K + C) * 2u; voffB[i] = (unsigned)(Rb * K + C) * 2u; }
    const size_t kstep = (size_t)(BK * 2);
    const size_t hstep = (size_t)HALF * K * 2;
    const size_t tstep = 2 * hstep;
    const unsigned ldsw = (unsigned)wid * 1024u;
    const int aoff = lds_byte(wr * 64 + fr, fq * 8), boff = lds_byte(wc * 32 + fr, fq * 8);
#define PG8_SA(b, h) (((b) * 2 + (h)) * HTB)
#define PG8_SB(b, h) ((4 + (b) * 2 + (h)) * HTB)
#define PG8_STAGE(bufoff, gbase, voff) do { const char* gb_ = (const char*)(gbase); asm volatile("" : "+s"(gb_));     \
        _Pragma("unroll") for (int _i = 0; _i < 2; ++_i) \
        __builtin_amdgcn_global_load_lds((const unsigned*)(gb_ + (voff)[_i]), (PG8_LAS unsigned*)(lds + (bufoff) + ldsw + _i * 8192), 16, 0, 0); } while (0)
#define PG8_LDA(dst, b, h) do { _Pragma("unroll") for (int m = 0; m < 4; ++m) _Pragma("unroll") for (int k = 0; k < 2; ++k) dst[m][k] = *(const PG8_LAS bf16x8*)(lds + PG8_SA(b, h) + aoff + m * 2048 + k * 1024); } while (0)
#define PG8_LDB(dst, b, h) do { _Pragma("unroll") for (int n = 0; n < 2; ++n) _Pragma("unroll") for (int k = 0; k < 2; ++k) dst[n][k] = *(const PG8_LAS bf16x8*)(lds + PG8_SB(b, h) + boff + n * 2048 + k * 1024); } while (0)
#define PG8_MMA(ai, bj, At, Bt) do { __builtin_amdgcn_s_setprio(1); _Pragma("unroll") for (int m = 0; m < 4; ++m) _Pragma("unroll") for (int n = 0; n < 2; ++n) _Pragma("unroll") for (int k = 0; k < 2; ++k) \
        acc[ai][bj][m][n] = __builtin_amdgcn_mfma_f32_16x16x32_bf16(Bt[n][k], At[m][k], acc[ai][bj][m][n], 0, 0, 0); __builtin_amdgcn_s_setprio(0); } while (0)
#define PG8_MMA0(ai, bj, At, Bt) do { if (zc) { __builtin_amdgcn_s_setprio(1); const f32x4 z4_ = (f32x4){0.f, 0.f, 0.f, 0.f}; _Pragma("unroll") for (int m = 0; m < 4; ++m) _Pragma("unroll") for (int n = 0; n < 2; ++n) { \
        acc[ai][bj][m][n] = __builtin_amdgcn_mfma_f32_16x16x32_bf16(Bt[n][0], At[m][0], z4_, 0, 0, 0); acc[ai][bj][m][n] = __builtin_amdgcn_mfma_f32_16x16x32_bf16(Bt[n][1], At[m][1], acc[ai][bj][m][n], 0, 0, 0); } \
        __builtin_amdgcn_s_setprio(0); } else PG8_MMA(ai, bj, At, Bt); } while (0)
#define PG8_WAIT_V(n) asm volatile("s_waitcnt vmcnt(" #n ")" ::: "memory")
#define PG8_WAIT_L(n) asm volatile("s_waitcnt lgkmcnt(" #n ")" ::: "memory")
#define PG8_BAR __builtin_amdgcn_s_barrier()
#define PG8_SCHED __builtin_amdgcn_sched_barrier(0)
    Unit cur, nxt; int ui = 0;
    if (!S.next(0, cur)) return;
    f32x4 acc[2][2][4][2];
    bf16x8 At[4][2], B0[2][2], B1[2][2];
    const char* cA = (const char*)g.A1 + (size_t)cur.pm * tstep; const char* cB = (const char*)g.B1 + (size_t)cur.pn * tstep;
    S.a_ready(cur);
    if constexpr (SP2) {
        PG8_STAGE(PG8_SB(0, 0), cB, voffB); PG8_STAGE(PG8_SB(0, 1), cB + hstep, voffB); PG8_STAGE(PG8_SA(0, 0), cA, voffA); PG8_STAGE(PG8_SA(0, 1), cA + hstep, voffA);
        if (wr == 1) PG8_BAR;
        PG8_WAIT_V(2); PG8_BAR;
        PG8_STAGE(PG8_SB(1, 0), cB + kstep, voffB); PG8_STAGE(PG8_SB(1, 1), cB + hstep + kstep, voffB);
        PG8_WAIT_V(6); PG8_BAR;
    } else {
        PG8_STAGE(PG8_SB(0, 0), cB, voffB); PG8_STAGE(PG8_SA(0, 0), cA, voffA); PG8_STAGE(PG8_SB(0, 1), cB + hstep, voffB); PG8_STAGE(PG8_SA(0, 1), cA + hstep, voffA);
        if (wr == 1) PG8_BAR;
        PG8_WAIT_V(4); PG8_BAR;
        PG8_STAGE(PG8_SB(1, 0), cB + kstep, voffB); PG8_STAGE(PG8_SA(1, 0), cA + kstep, voffA); PG8_STAGE(PG8_SB(1, 1), cB + hstep + kstep, voffB);
        PG8_WAIT_V(6); PG8_BAR;
    }
    for (;;) {
        bool has_next; const char* nA; const char* nB; int nnt;
        if (seg == 0) { has_next = true; nA = (const char*)g.A2 + (size_t)cur.pm * tstep; nB = (const char*)g.B2 + (size_t)cur.pn * tstep; nnt = g.nt2; }
        else { has_next = S.next(ui + 1, nxt); nA = has_next ? (const char*)g.A1 + (size_t)nxt.pm * tstep : cA; nB = has_next ? (const char*)g.B1 + (size_t)nxt.pn * tstep : cB; nnt = g.nt1; }
        for (int t = 0; t < nt; t += 2) {
            const bool last = (t == nt - 2); const bool zc = (t == 0) && (seg == 0);
            asm volatile("" : "+v"(voffA[0]), "+v"(voffA[1]), "+v"(voffB[0]), "+v"(voffB[1]));
            const char* a1 = cA + (size_t)(t + 1) * kstep;
            const char* a2 = last ? nA : cA + (size_t)(t + 2) * kstep; const char* b2 = last ? nB : cB + (size_t)(t + 2) * kstep;
            const char* a3 = a2 + kstep; const char* b3 = b2 + kstep;
            if (last && has_next) S.a_ready(nxt);
            if constexpr (SP2) {
            PG8_LDB(B0, 0, 0); PG8_LDB(B1, 0, 1); PG8_SCHED; PG8_LDA(At, 0, 0); PG8_STAGE(PG8_SA(1, 0), a1, voffA); PG8_STAGE(PG8_SA(1, 1), a1 + hstep, voffA);
            PG8_WAIT_V(8); PG8_WAIT_L(0); PG8_BAR; PG8_MMA0(0, 0, At, B0); PG8_MMA0(0, 1, At, B1); PG8_BAR; PG8_SCHED;
            PG8_LDA(At, 0, 1); PG8_STAGE(PG8_SB(0, 0), b2, voffB); PG8_STAGE(PG8_SB(0, 1), b2 + hstep, voffB);
            PG8_WAIT_V(6); PG8_WAIT_L(0); PG8_BAR; PG8_MMA0(1, 0, At, B0); PG8_MMA0(1, 1, At, B1); PG8_BAR; PG8_SCHED;
            PG8_LDB(B0, 1, 0); PG8_LDB(B1, 1, 1); PG8_SCHED; PG8_LDA(At, 1, 0); PG8_STAGE(PG8_SA(0, 0), a2, voffA); PG8_STAGE(PG8_SA(0, 1), a2 + hstep, voffA);
            PG8_WAIT_V(8); PG8_WAIT_L(0); PG8_BAR; PG8_MMA(0, 0, At, B0); PG8_MMA(0, 1, At, B1); PG8_BAR; PG8_SCHED;
            PG8_LDA(At, 1, 1); PG8_STAGE(PG8_SB(1, 0), b3, voffB); PG8_STAGE(PG8_SB(1, 1), b3 + hstep, voffB);
            PG8_WAIT_V(6); PG8_WAIT_L(0); PG8_BAR; PG8_MMA(1, 0, At, B0); PG8_MMA(1, 1, At, B1); PG8_BAR; PG8_SCHED;
            } else {
            PG8_LDB(B0, 0, 0); PG8_SCHED; PG8_LDA(At, 0, 0); PG8_STAGE(PG8_SA(1, 1), a1 + hstep, voffA);
            PG8_WAIT_L(8); PG8_BAR; PG8_WAIT_L(0); PG8_MMA(0, 0, At, B0); PG8_BAR; PG8_SCHED;
            PG8_LDB(B1, 0, 1); PG8_STAGE(PG8_SB(0, 0), b2, voffB);
            PG8_BAR; PG8_WAIT_L(0); PG8_MMA(0, 1, At, B1); PG8_BAR;
            PG8_LDA(At, 0, 1); PG8_STAGE(PG8_SA(0, 0), a2, voffA);
            PG8_BAR; PG8_WAIT_L(0); PG8_MMA(1, 0, At, B0); PG8_BAR; PG8_SCHED;
            PG8_STAGE(PG8_SB(0, 1), b2 + hstep, voffB);
            PG8_WAIT_V(6); PG8_BAR; PG8_MMA(1, 1, At, B1); PG8_BAR;
            PG8_LDB(B0, 1, 0); PG8_SCHED; PG8_LDA(At, 1, 0); PG8_STAGE(PG8_SA(0, 1), a2 + hstep, voffA);
            PG8_WAIT_L(8); PG8_BAR; PG8_WAIT_L(0); PG8_MMA(0, 0, At, B0); PG8_BAR; PG8_SCHED;
            PG8_LDB(B1, 1, 1); PG8_STAGE(PG8_SB(1, 0), b3, voffB);
            PG8_BAR; PG8_WAIT_L(0); PG8_MMA(0, 1, At, B1); PG8_BAR;
            PG8_LDA(At, 1, 1); PG8_STAGE(PG8_SA(1, 0), a3, voffA);
            PG8_BAR; PG8_WAIT_L(0); PG8_MMA(1, 0, At, B0); PG8_BAR; PG8_SCHED;
            PG8_STAGE(PG8_SB(1, 1), b3 + hstep, voffB);
            PG8_WAIT_V(6); PG8_BAR; PG8_MMA(1, 1, At, B1); PG8_BAR;
            }
        }
        if constexpr (ALIGN_EPI) { if (wr == 0) PG8_BAR; }
        if (seg == 0) Mm(acc, cur, wr, wc, fr, fq); else { E(acc, cur, wr, wc, fr, fq); S.done(cur); }
        if (!has_next) break;
        if (seg == 1) { cur = nxt; ++ui; }
        cA = nA; cB = nB; nt = nnt; seg ^= 1;
        if constexpr (ALIGN_EPI) { if (wr == 1) PG8_BAR; }
    }
    PG8_WAIT_V(0);
    if constexpr (!ALIGN_EPI) { if (wr == 0) PG8_BAR; }
    PG8_BAR;
#undef PG8_SA
#undef PG8_SB
#undef PG8_STAGE
#undef PG8_LDA
#undef PG8_LDB
#undef PG8_MMA
#undef PG8_MMA0
#undef PG8_WAIT_V
#undef PG8_WAIT_L
#undef PG8_BAR
#undef PG8_SCHED
}
}
#define GAS __attribute__((address_space(1)))
#define LAS __attribute__((address_space(3)))
typedef unsigned short bf16;
typedef unsigned v4u __attribute__((ext_vector_type(4)));
typedef unsigned v2u __attribute__((ext_vector_type(2)));
typedef float f32x4 __attribute__((ext_vector_type(4)));
typedef short bf16x8 __attribute__((ext_vector_type(8)));

constexpr int DM = 2048, NCTX = 8192, NLAT = 16384, MTOK = 24576, DEPTH = 4;
constexpr int NH = 16, NKV = 4, HD = 128, DKV = 512, DCONV = 1024, DFF = 5632;
constexpr int NIN = 10240, NGU = 11264, NMOD = 9, ADA_N = 12288;
constexpr float EPS = 1e-6f;

constexpr size_t MiB = 1u << 20;
constexpr size_t WS_CTL = 0, CTL_ZERO_BYTES = 32768;
constexpr size_t WS_MODS = 1 * MiB;
constexpr size_t WS_ROPE = 3 * MiB;
constexpr size_t WS_PART = 4 * MiB;
constexpr size_t WS_KC = 18 * MiB, WS_VC = 26 * MiB;
constexpr size_t WS_W = 34 * MiB;
constexpr size_t W_LAYER = 130 * MiB, W_IN = 0, W_A = 40 * MiB, W_B = 48 * MiB, W_O = 56 * MiB, W_GU = 64 * MiB, W_D = 108 * MiB;
constexpr size_t WS_HB = 554 * MiB;
constexpr size_t WS_Q = 650 * MiB;
constexpr size_t WS_K = 746 * MiB, WS_V = 770 * MiB;
constexpr size_t WS_CVB = 794 * MiB;
constexpr size_t WS_U = 890 * MiB;
constexpr size_t WS_R = 938 * MiB, WS_SB = 1034 * MiB;
constexpr size_t WS_ACT = 1130 * MiB;
constexpr size_t WS_X = 1394 * MiB;
constexpr size_t WS_END = 1490 * MiB;
constexpr int LDCV = 2048;
constexpr size_t OUT_YS = (size_t)NCTX * DM, OUT_NK = (size_t)MTOK * DM, OUT_NV = OUT_NK + (size_t)32 * 4 * 256 * 512;

struct Params {
    const float *x_prompt, *x_sample, *cache_k, *cache_v, *c, *c_ctx, *w_ada, *b_ada, *norm1, *w_in, *q_gain, *k_gain, *conv_w, *conv_b,
                *w_a, *w_b, *w_o, *norm2, *w_gate, *w_up, *w_down, *norm_f;
    float* out; unsigned char* ws;
};

__device__ __forceinline__ unsigned f2bf(float f) { unsigned u = __builtin_bit_cast(unsigned, f); return (u + 0x7fffu + ((u >> 16) & 1u)) >> 16; }
__device__ __forceinline__ unsigned pk2(float lo, float hi) { return f2bf(lo) | (f2bf(hi) << 16); }
__device__ __forceinline__ float bf2f(unsigned b) { return __builtin_bit_cast(float, b << 16); }
__device__ __forceinline__ float bflo(unsigned w) { return __builtin_bit_cast(float, w << 16); }
__device__ __forceinline__ float bfhi(unsigned w) { return __builtin_bit_cast(float, w & 0xffff0000u); }
__device__ __forceinline__ float wave_sum(float v) {
#define SWZ_XOR(k) v += __builtin_bit_cast(float, __builtin_amdgcn_ds_swizzle(__builtin_bit_cast(int, v), 0x1F | ((k) << 10)))
    SWZ_XOR(1); SWZ_XOR(2); SWZ_XOR(4); SWZ_XOR(8); SWZ_XOR(16);
#undef SWZ_XOR
    return __builtin_bit_cast(float, __builtin_amdgcn_readlane(__builtin_bit_cast(int, v), 0)) + __builtin_bit_cast(float, __builtin_amdgcn_readlane(__builtin_bit_cast(int, v), 32));
}
__device__ __forceinline__ float sigmoidf_(float v) { return 1.f / (1.f + __expf(-v)); }

__host__ __device__ __forceinline__ int c8_of_ph(int ph) { const int wc = ph >> 5, n = (ph >> 4) & 1, fq = (ph >> 2) & 3, j = ph & 3; return 32 * wc + 8 * fq + 4 * n + j; }
__host__ __device__ __forceinline__ int ph_of_c8(int c) { const int wc = c >> 5, fq = (c >> 3) & 3, n = (c >> 2) & 1, j = c & 3; return 32 * wc + 16 * n + 4 * fq + j; }
__host__ __device__ __forceinline__ int d_of_ph(int ph) { const int wc = ph >> 5, n = (ph >> 4) & 1, fq = (ph >> 2) & 3, j = ph & 3; return 16 * wc + 4 * fq + j + 64 * n; }
__host__ __device__ __forceinline__ int ph_of_d(int d) { const int n = d >> 6, r = d & 63, wc = r >> 4, fq = (r >> 2) & 3, j = r & 3; return 32 * wc + 16 * n + 4 * fq + j; }
__host__ __device__ __forceinline__ int s_of_d(int d) { return c8_of_ph(ph_of_d(d)); }
__host__ __device__ __forceinline__ int d_of_s(int s) { return d_of_ph(ph_of_c8(s)); }
__host__ __device__ __forceinline__ int win_col(int np) {
    const int tile = np >> 8, bj = (np >> 7) & 1, ph = np & 127;
    if (tile < 8)  return (2 * tile + bj) * 128 + d_of_ph(ph);
    if (tile < 10) return 2048 + (2 * (tile - 8) + bj) * 128 + d_of_ph(ph);
    if (tile < 12) return 2560 + (tile - 10) * 256 + bj * 128 + c8_of_ph(ph);
    if (tile < 16) return 3072 + (tile - 12) * 256 + bj * 128 + c8_of_ph(ph);
    if (tile < 24) return (bj ? 5120 : 4096) + (tile - 16) * 128 + c8_of_ph(ph);
    return (bj ? 8192 : 6144) + (tile - 24) * 128 + c8_of_ph(ph);
}
__device__ __forceinline__ int mod_index(int m) { return m < NCTX ? 0 : 1 + ((m - NCTX) >> 11); }

__device__ __forceinline__ void ph_ada_partials(const Params& p, LAS float* st, int gw, int ngw, int lane, int tid, int nthr) {
    for (int i = tid; i < NMOD * DM; i += nthr) { const int ci = i / DM, d = i % DM; const float v = ci == 0 ? p.c_ctx[d] : p.c[(ci - 1) * DM + d]; st[d * 12 + ci] = v / (1.f + expf(-v)); }
    __syncthreads();
    float* PART = (float*)(p.ws + WS_PART);
    for (int it = gw; it < DEPTH * 48 * 8; it += ngw) {
        const int ks = it & 7, cb = (it >> 3) % 48, l = it / (8 * 48);
        const float* w = p.w_ada + ((size_t)l * DM + ks * 256) * ADA_N + cb * 256 + lane * 4;
        f32x4 acc[NMOD];
#pragma unroll
        for (int ci = 0; ci < NMOD; ++ci) acc[ci] = (f32x4){0.f, 0.f, 0.f, 0.f};
#pragma unroll 8
        for (int d = 0; d < 256; ++d) {
            const f32x4 wv = *(const f32x4*)(w + (size_t)d * ADA_N); const LAS float* s = st + (ks * 256 + d) * 12;
            const f32x4 s0 = *(const LAS f32x4*)s, s1 = *(const LAS f32x4*)(s + 4); const float s8 = s[8];
            acc[0] += s0[0] * wv; acc[1] += s0[1] * wv; acc[2] += s0[2] * wv; acc[3] += s0[3] * wv;
            acc[4] += s1[0] * wv; acc[5] += s1[1] * wv; acc[6] += s1[2] * wv; acc[7] += s1[3] * wv; acc[8] += s8 * wv;
        }
#pragma unroll
        for (int ci = 0; ci < NMOD; ++ci) *(f32x4*)(PART + ((size_t)((ks * DEPTH + l) * NMOD + ci)) * ADA_N + cb * 256 + lane * 4) = acc[ci];
    }
}
__device__ __forceinline__ void ph_ada_reduce(const Params& p, int gt, int ngt) {
    const float* PART = (const float*)(p.ws + WS_PART); float* MODS = (float*)(p.ws + WS_MODS);
    for (int i = gt; i < DEPTH * NMOD * (ADA_N / 4); i += ngt) {
        const int e4 = i % (ADA_N / 4), ci = (i / (ADA_N / 4)) % NMOD, l = i / ((ADA_N / 4) * NMOD);
        f32x4 s = *(const f32x4*)(p.b_ada + (size_t)l * ADA_N + e4 * 4);
#pragma unroll
        for (int ks = 0; ks < 8; ++ks) s += *(const f32x4*)(PART + ((size_t)((ks * DEPTH + l) * NMOD + ci)) * ADA_N + e4 * 4);
        *(f32x4*)(MODS + ((size_t)(l * NMOD + ci)) * ADA_N + e4 * 4) = s;
    }
}
__device__ __forceinline__ const float* x_in_row(const Params& p, int m) { return m < NCTX ? p.x_prompt + (size_t)m * DM : p.x_sample + (size_t)(m - NCTX) * DM; }
__device__ __forceinline__ void ph_misc_prep(const Params& p, int gt, int ngt) {
    float* RC = (float*)(p.ws + WS_ROPE); float* RS = RC + 2048 * 64;
    for (int i = gt; i < 2048 * 64; i += ngt) { const int t = i >> 6, ii = i & 63, f = ii & 31; const float inv = powf(10000.0f, -(float)f / 32.0f);
        const float ang = (ii < 32 ? (float)(t >> 6) : (float)(t & 63)) * inv; float sn, cs; sincosf(ang, &sn, &cs); RC[i] = cs; RS[i] = sn; }
    bf16* KC = (bf16*)(p.ws + WS_KC); bf16* VC = (bf16*)(p.ws + WS_VC);
    for (int i = gt; i < DEPTH * 8 * 256 * 64; i += ngt) {
        const int g8 = i & 15, kvh = (i >> 4) & 3, t = (i >> 6) & 255, b = (i >> 14) & 7, l = i >> 17;
        const size_t src = ((((size_t)b * DEPTH + l) * 256 + t) * NKV + kvh) * HD, dst = (((size_t)l * 8 + b) * 256 + t) * DKV + kvh * HD + g8 * 8;
        { const f32x4 a = *(const f32x4*)(p.cache_v + src + g8 * 8), c = *(const f32x4*)(p.cache_v + src + g8 * 8 + 4);
          *(v4u*)(VC + dst) = (v4u){pk2(a[0], a[1]), pk2(a[2], a[3]), pk2(c[0], c[1]), pk2(c[2], c[3])}; }
        { const int d0 = d_of_s(g8 * 8);
          const f32x4 a = *(const f32x4*)(p.cache_k + src + d0), c = *(const f32x4*)(p.cache_k + src + d0 + 64);
          *(v4u*)(KC + dst) = (v4u){pk2(a[0], a[1]), pk2(a[2], a[3]), pk2(c[0], c[1]), pk2(c[2], c[3])}; }
    }
}
__device__ __forceinline__ void wt_item(const float* W0, const float* W1, int K, int Nsrc, int Nphys, int kind, bf16* WT, int ldo, LAS float* scr, int item, int lane) {
    const int nblk = Nphys / 32, kb = item / nblk, nb = item % nblk, k0 = 64 * kb, n0 = 32 * nb;
    const int g = lane & 7, kq = lane >> 3, np = n0 + 4 * g; const float* W = W0; int col;
    if (kind == 0) col = np;
    else if (kind == 1) col = (np & ~127) | c8_of_ph(np & 127);
    else if (kind == 2) col = win_col(np);
    else { col = (np >> 8) * 128 + c8_of_ph(np & 127); if ((np >> 7) & 1) W = W1; }
    f32x4 v[8];
#pragma unroll
    for (int i = 0; i < 8; ++i) v[i] = *(const f32x4*)(W + (size_t)(k0 + 8 * i + kq) * Nsrc + col);
#pragma unroll
    for (int i = 0; i < 8; ++i)
#pragma unroll
        for (int j = 0; j < 4; ++j) scr[(8 * i + kq) * 33 + 4 * g + j] = v[i][j];
    asm volatile("s_waitcnt lgkmcnt(0)" ::: "memory");
    const int c = lane & 7;
#pragma unroll
    for (int j = 0; j < 4; ++j) { const int n = (lane >> 3) + 8 * j; const LAS float* s = scr + (8 * c) * 33 + n;
        v4u o; o.x = pk2(s[0 * 33], s[1 * 33]); o.y = pk2(s[2 * 33], s[3 * 33]); o.z = pk2(s[4 * 33], s[5 * 33]); o.w = pk2(s[6 * 33], s[7 * 33]);
        *(v4u*)(WT + (size_t)(n0 + n) * ldo + k0 + 8 * c) = o; }
    asm volatile("s_waitcnt lgkmcnt(0)" ::: "memory");
}
constexpr int WI_IN = (DM / 64) * (NIN / 32), WI_A = (DCONV / 64) * (DM / 32), WI_B = (DM / 64) * (DM / 32), WI_O = WI_B, WI_GU = (DM / 64) * (NGU / 32), WI_D = (DFF / 64) * (DM / 32);
constexpr int WI_LAYER = WI_IN + WI_A + WI_B + WI_O + WI_GU + WI_D;
constexpr int WI_TAIL = 12288;
__device__ __forceinline__ void wt_dispatch(const Params& p, LAS float* scr, int l, int r, int lane) {
    unsigned char* wl = p.ws + WS_W + (size_t)l * W_LAYER;
    if (r < WI_IN) { wt_item(p.w_in + (size_t)l * DM * NIN, nullptr, DM, NIN, NIN, 2, (bf16*)(wl + W_IN), DM, scr, r, lane); return; } r -= WI_IN;
    if (r < WI_A)  { wt_item(p.w_a + (size_t)l * DCONV * DM, nullptr, DCONV, DM, DM, 1, (bf16*)(wl + W_A), DM  , scr, r, lane); return; } r -= WI_A;
    if (r < WI_B)  { wt_item(p.w_b + (size_t)l * DM * DM, nullptr, DM, DM, DM, 1, (bf16*)(wl + W_B), DM, scr, r, lane); return; } r -= WI_B;
    if (r < WI_O)  { wt_item(p.w_o + (size_t)l * DM * DM, nullptr, DM, DM, DM, 1, (bf16*)(wl + W_O), DM, scr, r, lane); return; } r -= WI_O;
    if (r < WI_GU) { wt_item(p.w_gate + (size_t)l * DM * DFF, p.w_up + (size_t)l * DM * DFF, DM, DFF, NGU, 3, (bf16*)(wl + W_GU), DM, scr, r, lane); return; } r -= WI_GU;
    wt_item(p.w_down + (size_t)l * DFF * DM, nullptr, DFF, DM, DM, 1, (bf16*)(wl + W_D), DFF, scr, r, lane);
}
__device__ __forceinline__ void ph_weights(const Params& p, LAS float* scr  , int gw, int ngw, int lane) {
    constexpr int PER = WI_LAYER - WI_TAIL, TOT = WI_LAYER + (DEPTH - 1) * PER;
    for (int it = gw; it < TOT; it += ngw) {
        int l = 0, r = it; if (it >= WI_LAYER) { l = 1 + (it - WI_LAYER) / PER; r = (it - WI_LAYER) % PER; }
        wt_dispatch(p, scr, l, r, lane);
    }
}
__device__ __forceinline__ void ph_weights_tail(const Params& p, LAS float* scr, int l, int tw, int ntw, int lane) {
    for (int it = WI_LAYER - WI_TAIL + tw; it < WI_LAYER; it += ntw) wt_dispatch(p, scr, l, it, lane);
}
__device__ __forceinline__ void norm_load_row(const Params& p, bool from_in, int m, int lane, f32x4 (&v)[8]) {
    if (from_in) { const float* xr = x_in_row(p, m);
#pragma unroll
        for (int j = 0; j < 8; ++j) v[j] = *(const f32x4*)(xr + ((j >> 1) * 64 + lane) * 8 + (j & 1) * 4); }
    else { const bf16* xr = (const bf16*)(p.ws + WS_X) + (size_t)m * DM;
#pragma unroll
        for (int jj = 0; jj < 4; ++jj) { const v4u w = *(const v4u*)(xr + (jj * 64 + lane) * 8);
            v[2 * jj] = (f32x4){bflo(w[0]), bfhi(w[0]), bflo(w[1]), bfhi(w[1])}; v[2 * jj + 1] = (f32x4){bflo(w[2]), bfhi(w[2]), bflo(w[3]), bfhi(w[3])}; } }
}
__device__ __forceinline__ void ph_norm(const Params& p, int layer, int which, int gw, int ngw, int lane) {
    const float* g = (which ? p.norm2 : p.norm1) + (size_t)layer * DM; const float* MODS = (const float*)(p.ws + WS_MODS); bf16* HB = (bf16*)(p.ws + WS_HB);
    constexpr int rpw = MTOK / 2048; const int m0 = gw * rpw; (void)ngw; const bool from_in = (layer == 0 && which == 0);
    f32x4 gs[8], sh[8], v[8], vn[8]; int ci_cur = -1;
    norm_load_row(p, from_in, m0, lane, v);
    for (int r = 0; r < rpw; ++r) {
        const int m = m0 + r, ci = mod_index(m);
        if (ci != ci_cur) { ci_cur = ci; const float* mod = MODS + ((size_t)(layer * NMOD + ci) * 6 + 3 * which) * DM;
#pragma unroll
            for (int j = 0; j < 8; ++j) { const int c = ((j >> 1) * 64 + lane) * 8 + (j & 1) * 4; sh[j] = *(const f32x4*)(mod + c); gs[j] = *(const f32x4*)(g + c) * (*(const f32x4*)(mod + DM + c) + 1.0f); } }
        if (r + 1 < rpw) norm_load_row(p, from_in, m + 1, lane, vn);
        float ss = 0.f;
#pragma unroll
        for (int j = 0; j < 8; ++j) ss += (v[j][0] * v[j][0] + v[j][1] * v[j][1]) + (v[j][2] * v[j][2] + v[j][3] * v[j][3]);
        const float rstd = 1.0f / sqrtf(wave_sum(ss) * (1.0f / DM) + EPS);
#pragma unroll
        for (int jj = 0; jj < 4; ++jj) { const f32x4 y0 = (v[2 * jj] * rstd) * gs[2 * jj] + sh[2 * jj], y1 = (v[2 * jj + 1] * rstd) * gs[2 * jj + 1] + sh[2 * jj + 1];
            *(v4u*)(HB + (size_t)m * DM + (jj * 64 + lane) * 8) = (v4u){pk2(y0[0], y0[1]), pk2(y0[2], y0[3]), pk2(y1[0], y1[1]), pk2(y1[2], y1[3])}; }
#pragma unroll
        for (int j = 0; j < 8; ++j) v[j] = vn[j];
    }
}
__device__ __forceinline__ void ph_conv(const Params& p, int layer, int gt, int ngt) {
    bf16* CVB = (bf16*)(p.ws + WS_CVB); const bf16* U = (const bf16*)(p.ws + WS_U);
    const int ch0 = (gt & 127) * 8; const float* cw = p.conv_w + (size_t)layer * 3 * DCONV + ch0; const float* cb = p.conv_b + (size_t)layer * DCONV + ch0;
    float w0[8], w1[8], w2[8], wb[8];
#pragma unroll
    for (int k = 0; k < 8; ++k) { w0[k] = cw[k]; w1[k] = cw[DCONV + k]; w2[k] = cw[2 * DCONV + k]; wb[k] = cb[k]; }
    for (int i = gt; i < MTOK * (DCONV / 8); i += ngt) {
        const int m = i >> 7; int t, S; if (m < NCTX) { t = m & 255; S = 256; } else { t = (m - NCTX) & 2047; S = 2048; }
        const v4u z = (v4u){0u, 0u, 0u, 0u};
        const v4u b8 = *(const v4u*)(CVB + (size_t)m * LDCV + ch0), u0 = *(const v4u*)(U + (size_t)m * DCONV + ch0);
        const v4u um = t > 0 ? *(const v4u*)(U + (size_t)(m - 1) * DCONV + ch0) : z, up = t < S - 1 ? *(const v4u*)(U + (size_t)(m + 1) * DCONV + ch0) : z;
        float y[8];
#pragma unroll
        for (int k = 0; k < 8; ++k) { const int w = k >> 1; const bool hi = k & 1;
            const float bv = hi ? bfhi(b8[w]) : bflo(b8[w]), a0 = hi ? bfhi(u0[w]) : bflo(u0[w]), am = hi ? bfhi(um[w]) : bflo(um[w]), ap = hi ? bfhi(up[w]) : bflo(up[w]);
            y[k] = bv * (w0[k] * am + w1[k] * a0 + w2[k] * ap + wb[k]); }
        *(v4u*)(CVB + (size_t)m * LDCV + ch0) = (v4u){pk2(y[0], y[1]), pk2(y[2], y[3]), pk2(y[4], y[5]), pk2(y[6], y[7])};
    }
}
__device__ __forceinline__ void ph_final_norm(const Params& p, int gw, int ngw, int lane) {
    constexpr int rpw = MTOK / 2048; const int m0 = gw * rpw; (void)ngw; f32x4 gf[8], v[8], vn[8];
#pragma unroll
    for (int j = 0; j < 8; ++j) gf[j] = *(const f32x4*)(p.norm_f + ((j >> 1) * 64 + lane) * 8 + (j & 1) * 4);
    norm_load_row(p, false, m0, lane, v);
    for (int r = 0; r < rpw; ++r) {
        float* yr = p.out + (size_t)(m0 + r) * DM;
        if (r + 1 < rpw) norm_load_row(p, false, m0 + r + 1, lane, vn);
        float ss = 0.f;
#pragma unroll
        for (int j = 0; j < 8; ++j) ss += (v[j][0] * v[j][0] + v[j][1] * v[j][1]) + (v[j][2] * v[j][2] + v[j][3] * v[j][3]);
        const float rstd = 1.0f / sqrtf(wave_sum(ss) * (1.0f / DM) + EPS);
#pragma unroll
        for (int j = 0; j < 8; ++j) *(f32x4*)(yr + ((j >> 1) * 64 + lane) * 8 + (j & 1) * 4) = (v[j] * rstd) * gf[j];
#pragma unroll
        for (int j = 0; j < 8; ++j) v[j] = vn[j];
    }
}
namespace pg8 {
typedef unsigned u32x4e __attribute__((ext_vector_type(4)));
__device__ __forceinline__ u32x4e pack8(const f32x4 a, const f32x4 b) { u32x4e w; w.x = cvt_pk_bf16(a[0], a[1]); w.y = cvt_pk_bf16(a[2], a[3]); w.z = cvt_pk_bf16(b[0], b[1]); w.w = cvt_pk_bf16(b[2], b[3]); return w; }
__device__ __forceinline__ f32x4 unpack_lo(const u32x4e w) { return (f32x4){__builtin_bit_cast(float, w.x << 16), __builtin_bit_cast(float, w.x & 0xffff0000u), __builtin_bit_cast(float, w.y << 16), __builtin_bit_cast(float, w.y & 0xffff0000u)}; }
__device__ __forceinline__ f32x4 unpack_hi(const u32x4e w) { return (f32x4){__builtin_bit_cast(float, w.z << 16), __builtin_bit_cast(float, w.z & 0xffff0000u), __builtin_bit_cast(float, w.w << 16), __builtin_bit_cast(float, w.w & 0xffff0000u)}; }
__device__ __forceinline__ float fsig(float v) { return __builtin_amdgcn_rcpf(1.0f + __builtin_amdgcn_exp2f(-1.4426950408889634f * v)); }
__device__ __forceinline__ f32x4 fsig4(const f32x4 v) { return (f32x4){fsig(v[0]), fsig(v[1]), fsig(v[2]), fsig(v[3])}; }

struct EpiIn {
    static constexpr bool PERM = false, AFTER_DRAIN = false;
    unsigned char* ws_; float* out_; const float *qg, *kg; PG8_LAS float* P; int layer;
    __device__ __forceinline__ void operator()(const f32x4 (&acc)[2][2][4][2], const Unit& u, int wr, int wc, int fr, int fq) const {
        asm volatile("" : "+v"(fr), "+v"(fq));
        const int pn = u.pn, cq = wc * 32 + fq * 8; const bool lat = u.pm >= 32;
        GAS unsigned char* wsg = (GAS unsigned char*)ws_; GAS float* outg = (GAS float*)out_; asm volatile("" : "+s"(wsg), "+s"(outg));
        unsigned char* ws = (unsigned char*)wsg; float* outp = (float*)outg;
        bf16_t* const QB = (bf16_t*)(ws + WS_Q); bf16_t* const KB = (bf16_t*)(ws + WS_K); bf16_t* const VB = (bf16_t*)(ws + WS_V); bf16_t* const CVB = (bf16_t*)(ws + WS_CVB); bf16_t* const U = (bf16_t*)(ws + WS_U);
        bf16_t* const RR = (bf16_t*)(ws + WS_R); bf16_t* const SB = (bf16_t*)(ws + WS_SB); const float* const RC = (const float*)(ws + WS_ROPE); const float* const RS = RC + 2048 * 64;
        float* const NK = outp + OUT_NK; float* const NV = outp + OUT_NV;
        if (pn < 10) {
            const bool isk = pn >= 8; const float* gain = isk ? kg : qg;
            const f32x4 g0 = *(const f32x4*)(gain + wc * 16 + fq * 4), g1 = *(const f32x4*)(gain + 64 + wc * 16 + fq * 4);
#pragma unroll
            for (int ai = 0; ai < 2; ++ai)
#pragma unroll
                for (int m = 0; m < 4; ++m)
#pragma unroll
                    for (int bj = 0; bj < 2; ++bj) { const f32x4 a = acc[ai][bj][m][0], b = acc[ai][bj][m][1];
                        float s = ((a[0] * a[0] + a[1] * a[1]) + (a[2] * a[2] + a[3] * a[3])) + ((b[0] * b[0] + b[1] * b[1]) + (b[2] * b[2] + b[3] * b[3]));
                        s += __builtin_bit_cast(float, __builtin_amdgcn_ds_bpermute(((fq ^ 1) * 16 + fr) << 2, __builtin_bit_cast(int, s))); s += __builtin_bit_cast(float, __builtin_amdgcn_ds_bpermute(((fq ^ 2) * 16 + fr) << 2, __builtin_bit_cast(int, s)));
                        if (fq == 0) P[((ai * HALF + wr * 64 + m * 16 + fr) * 2 + bj) * 4 + wc] = s; }
            asm volatile("s_waitcnt lgkmcnt(0)" ::: "memory"); __builtin_amdgcn_s_barrier(); asm volatile("" ::: "memory");
#pragma unroll
            for (int ai = 0; ai < 2; ++ai) { f32x4 csv[4], snv[4];
#pragma unroll
                for (int m = 0; m < 4; ++m) { csv[m] = (f32x4){1.f, 1.f, 1.f, 1.f}; snv[m] = (f32x4){0.f, 0.f, 0.f, 0.f};
                    if (lat) { const int t = (u.pm * BM + ai * HALF + wr * 64 + m * 16 + fr - 8192) & 2047; csv[m] = *(const f32x4*)(RC + t * 64 + wc * 16 + fq * 4); snv[m] = *(const f32x4*)(RS + t * 64 + wc * 16 + fq * 4); } }
#pragma unroll
                for (int m = 0; m < 4; ++m) { const int r = ai * HALF + wr * 64 + m * 16 + fr, mrow = u.pm * BM + r; const f32x4 cs = csv[m], sn = snv[m];
#pragma unroll
                    for (int bj = 0; bj < 2; ++bj) { const f32x4 pp = *(const PG8_LAS f32x4*)(P + (r * 2 + bj) * 4);
                        const float rstd = 1.0f / sqrtf(((pp[0] + pp[1]) + (pp[2] + pp[3])) * (1.0f / 128.0f) + 1e-6f);
                        f32x4 y1 = acc[ai][bj][m][0] * rstd * g0, y2 = acc[ai][bj][m][1] * rstd * g1;
                        if (lat) { const f32x4 a = y1 * cs - y2 * sn, b = y2 * cs + y1 * sn; y1 = a; y2 = b; }
                        const int head = 2 * (pn - (isk ? 8 : 0)) + bj;
                        bf16_t* dst = isk ? KB + (size_t)mrow * 512 + head * 128 : QB + (size_t)mrow * 2048 + head * 128;
                        *(u32x4e*)(dst + cq) = pack8(y1, y2);
                        if (isk && !lat) { float* nk = NK + ((size_t)((mrow >> 8) * 4 + layer) * 256 + (mrow & 255)) * 512 + head * 128 + wc * 16 + fq * 4; *(f32x4*)nk = y1; *(f32x4*)(nk + 64) = y2; } } } }
        } else if (pn < 16) {
            const bool isv = pn < 12; const int ld = isv ? 512 : LDCV, ct = (isv ? pn - 10 : pn - 12) * 256; bf16_t* base = isv ? VB : CVB;
#pragma unroll
            for (int ai = 0; ai < 2; ++ai)
#pragma unroll
                for (int m = 0; m < 4; ++m) { const int mrow = u.pm * BM + ai * HALF + wr * 64 + m * 16 + fr;
#pragma unroll
                    for (int bj = 0; bj < 2; ++bj) { *(u32x4e*)(base + (size_t)mrow * ld + ct + bj * HALF + cq) = pack8(acc[ai][bj][m][0], acc[ai][bj][m][1]);
                        if (isv && !lat) { float* nv = NV + ((size_t)((mrow >> 8) * 4 + layer) * 256 + (mrow & 255)) * 512 + ct + bj * HALF + cq; *(f32x4*)nv = acc[ai][bj][m][0]; *(f32x4*)(nv + 4) = acc[ai][bj][m][1]; } } }
        } else if (pn < 24) {
#pragma unroll
            for (int ai = 0; ai < 2; ++ai)
#pragma unroll
                for (int m = 0; m < 4; ++m) { const int mrow = u.pm * BM + ai * HALF + wr * 64 + m * 16 + fr;
                    *(u32x4e*)(U + (size_t)mrow * 1024 + (pn - 16) * 128 + cq) = pack8(acc[ai][0][m][0] * acc[ai][1][m][0], acc[ai][0][m][1] * acc[ai][1][m][1]); }
        } else {
#pragma unroll
            for (int ai = 0; ai < 2; ++ai)
#pragma unroll
                for (int m = 0; m < 4; ++m) { const size_t o = (size_t)(u.pm * BM + ai * HALF + wr * 64 + m * 16 + fr) * 2048 + (pn - 24) * 128 + cq;
                    f32x4 rr[2], sb[2];
#pragma unroll
                    for (int n = 0; n < 2; ++n)
#pragma unroll
                        for (int j = 0; j < 4; ++j) { const float da = 1.0f + __builtin_amdgcn_exp2f(-1.4426950408889634f * acc[ai][0][m][n][j]), db = 1.0f + __builtin_amdgcn_exp2f(-1.4426950408889634f * acc[ai][1][m][n][j]);
                            rr[n][j] = db * __builtin_amdgcn_rcpf(da); sb[n][j] = __builtin_amdgcn_rcpf(db); }
                    *(u32x4e*)(RR + o) = pack8(rr[0], rr[1]);
                    *(u32x4e*)(SB + o) = pack8(sb[0], sb[1]); }
        }
    }
};
struct MidR {
    const bf16_t* RR;
    __device__ __forceinline__ void operator()(f32x4 (&acc)[2][2][4][2], const Unit& u, int wr, int wc, int fr, int fq) const {
        asm volatile("" : "+v"(fr), "+v"(fq));
#pragma unroll
        for (int ai = 0; ai < 2; ++ai) { u32x4e s[4][2];
#pragma unroll
            for (int m = 0; m < 4; ++m)
#pragma unroll
                for (int bj = 0; bj < 2; ++bj) s[m][bj] = *(const u32x4e*)(RR + (size_t)(u.pm * BM + ai * HALF + wr * 64 + m * 16 + fr) * 2048 + u.pn * BM + bj * HALF + wc * 32 + fq * 8);
#pragma unroll
            for (int m = 0; m < 4; ++m)
#pragma unroll
                for (int bj = 0; bj < 2; ++bj) { acc[ai][bj][m][0] *= unpack_lo(s[m][bj]); acc[ai][bj][m][1] *= unpack_hi(s[m][bj]); } }
    }
};
struct EpiB2 {
    static constexpr bool PERM = false, AFTER_DRAIN = false;
    const bf16_t* SB; bf16_t* MG;
    __device__ __forceinline__ void operator()(const f32x4 (&acc)[2][2][4][2], const Unit& u, int wr, int wc, int fr, int fq) const {
        asm volatile("" : "+v"(fr), "+v"(fq));
#pragma unroll
        for (int ai = 0; ai < 2; ++ai) { u32x4e s[4][2];
#pragma unroll
            for (int m = 0; m < 4; ++m)
#pragma unroll
                for (int bj = 0; bj < 2; ++bj) s[m][bj] = *(const u32x4e*)(SB + (size_t)(u.pm * BM + ai * HALF + wr * 64 + m * 16 + fr) * 2048 + u.pn * BM + bj * HALF + wc * 32 + fq * 8);
#pragma unroll
            for (int m = 0; m < 4; ++m)
#pragma unroll
                for (int bj = 0; bj < 2; ++bj) *(u32x4e*)(MG + (size_t)(u.pm * BM + ai * HALF + wr * 64 + m * 16 + fr) * 2048 + u.pn * BM + bj * HALF + wc * 32 + fq * 8) = pack8(unpack_lo(s[m][bj]) * acc[ai][bj][m][0], unpack_hi(s[m][bj]) * acc[ai][bj][m][1]); }
    }
};
struct EpiRes {
    static constexpr bool PERM = false, AFTER_DRAIN = false;
    bf16_t* XB; const float* mods; int chunk; const float* xp32; const float* xs32;
    __device__ __forceinline__ void operator()(const f32x4 (&acc)[2][2][4][2], const Unit& u, int wr, int wc, int fr, int fq) const {
        asm volatile("" : "+v"(fr), "+v"(fq));
        const int ci = u.pm < 32 ? 0 : 1 + ((u.pm - 32) >> 3); const float* gt = mods + ((size_t)ci * 6 + chunk) * 2048;
        const int col0 = u.pn * BM + wc * 32 + 8 * fq; f32x4 gv[2][2];
#pragma unroll
        for (int bj = 0; bj < 2; ++bj)
#pragma unroll
            for (int n = 0; n < 2; ++n) gv[bj][n] = *(const f32x4*)(gt + col0 + bj * HALF + n * 4);
        if (xp32) {
            const float* xin = u.pm < 32 ? xp32 + (size_t)(u.pm * BM) * 2048 : xs32 + (size_t)(u.pm * BM - 8192) * 2048;
#pragma unroll
            for (int ai = 0; ai < 2; ++ai)
#pragma unroll
                for (int mh = 0; mh < 2; ++mh) { f32x4 t[2][2][2];
#pragma unroll
                    for (int m2 = 0; m2 < 2; ++m2)
#pragma unroll
                        for (int bj = 0; bj < 2; ++bj)
#pragma unroll
                            for (int n = 0; n < 2; ++n) t[m2][bj][n] = *(const f32x4*)(xin + (size_t)(ai * HALF + wr * 64 + (2 * mh + m2) * 16 + fr) * 2048 + col0 + bj * HALF + n * 4);
#pragma unroll
                    for (int m2 = 0; m2 < 2; ++m2)
#pragma unroll
                        for (int bj = 0; bj < 2; ++bj) *(u32x4e*)(XB + (size_t)(u.pm * BM + ai * HALF + wr * 64 + (2 * mh + m2) * 16 + fr) * 2048 + col0 + bj * HALF) =
                            pack8(t[m2][bj][0] + gv[bj][0] * acc[ai][bj][2 * mh + m2][0], t[m2][bj][1] + gv[bj][1] * acc[ai][bj][2 * mh + m2][1]); }
            return;
        }
        u32x4e s[2][4][2];
#pragma unroll
        for (int ai = 0; ai < 2; ++ai)
#pragma unroll
            for (int m = 0; m < 4; ++m)
#pragma unroll
                for (int bj = 0; bj < 2; ++bj) s[ai][m][bj] = *(const u32x4e*)(XB + (size_t)(u.pm * BM + ai * HALF + wr * 64 + m * 16 + fr) * 2048 + col0 + bj * HALF);
#pragma unroll
        for (int ai = 0; ai < 2; ++ai)
#pragma unroll
            for (int m = 0; m < 4; ++m)
#pragma unroll
                for (int bj = 0; bj < 2; ++bj) *(u32x4e*)(XB + (size_t)(u.pm * BM + ai * HALF + wr * 64 + m * 16 + fr) * 2048 + col0 + bj * HALF) =
                    pack8(unpack_lo(s[ai][m][bj]) + gv[bj][0] * acc[ai][bj][m][0], unpack_hi(s[ai][m][bj]) + gv[bj][1] * acc[ai][bj][m][1]);
    }
};
struct EpiGU {
    static constexpr bool PERM = false, AFTER_DRAIN = false;
    bf16_t* ACT;
    __device__ __forceinline__ void operator()(const f32x4 (&acc)[2][2][4][2], const Unit& u, int wr, int wc, int fr, int fq) const {
        asm volatile("" : "+v"(fr), "+v"(fq));
#pragma unroll
        for (int ai = 0; ai < 2; ++ai)
#pragma unroll
            for (int m = 0; m < 4; ++m) { const f32x4 g0 = acc[ai][0][m][0], g1 = acc[ai][0][m][1];
                *(u32x4e*)(ACT + (size_t)(u.pm * BM + ai * HALF + wr * 64 + m * 16 + fr) * 5632 + u.pn * 128 + wc * 32 + fq * 8) = pack8(g0 * fsig4(g0) * acc[ai][1][m][0], g1 * fsig4(g1) * acc[ai][1][m][1]); }
    }
};
}
namespace att {
using bf16x8 = __attribute__((ext_vector_type(8))) short;
using s16x4  = __attribute__((ext_vector_type(4))) short;
using f32x16 = __attribute__((ext_vector_type(16))) float;
using u32x4  = __attribute__((ext_vector_type(4))) unsigned;
constexpr int   D = 128, NW = 8, QBLK = 32, KVBLK = 64, LDQ = 2048, LDK = 512, LDO = 2048;
constexpr float SCALE = 0.088388347648318440f, THR = 8.f;
constexpr size_t SHM_V = KVBLK * D * 2, SHM_K = KVBLK * D * 2, SHM_ATTN = 2 * SHM_V + 2 * SHM_K + NW * 64 * 4;
#define KSWZ(row, colB) ((row) * 256 + ((colB) ^ (((row) & 7) << 4)))
#define SBAR() __builtin_amdgcn_sched_barrier(0)
__device__ __forceinline__ int crow(int r, int hi) { return (r & 3) + 8 * (r >> 2) + 4 * hi; }
__device__ __forceinline__ unsigned cvtpk(float lo, float hi) { unsigned r; asm volatile("v_cvt_pk_bf16_f32 %0, %1, %2" : "=v"(r) : "v"(lo), "v"(hi)); return r; }
__device__ __forceinline__ void partialSM(f32x16& p0, f32x16& p1, float& m_reg, float& mn, float& alpha) {
  constexpr float C = SCALE * 1.4426950408889634f;
  float pmax = p0[0]; for (int r = 1; r < 16; ++r) pmax = fmaxf(pmax, p0[r]); for (int r = 0; r < 16; ++r) pmax = fmaxf(pmax, p1[r]);
  { auto rr = __builtin_amdgcn_permlane32_swap(__float_as_uint(pmax), __float_as_uint(pmax), false, false);
    pmax = fmaxf(__uint_as_float(rr[0]), __uint_as_float(rr[1])); }
  if (__builtin_expect(__all(pmax - m_reg <= THR / SCALE), 1)) { mn = m_reg; alpha = 1.f; }
  else { mn = fmaxf(m_reg, pmax); alpha = __builtin_amdgcn_exp2f((m_reg - mn) * C); m_reg = mn; }
  float mnC = -mn * C;
  for (int r = 0; r < 16; ++r) p0[r] = fmaf(p0[r], C, mnC); for (int r = 0; r < 16; ++r) p1[r] = fmaf(p1[r], C, mnC);
  for (int r = 0; r < 16; ++r) p0[r] = __builtin_amdgcn_exp2f(p0[r]);
}
__device__ __forceinline__ void finishSM(f32x16& p0, f32x16& p1, float alpha, float& l_reg, bf16x8& pa0, bf16x8& pa1, bf16x8& pa2, bf16x8& pa3) {
  for (int r = 0; r < 16; ++r) p1[r] = __builtin_amdgcn_exp2f(p1[r]);
  float ps = 0; for (int r = 0; r < 16; ++r) ps += p0[r]; for (int r = 0; r < 16; ++r) ps += p1[r];
  { auto rr = __builtin_amdgcn_permlane32_swap(__float_as_uint(ps), __float_as_uint(ps), false, false);
    ps = __uint_as_float(rr[0]) + __uint_as_float(rr[1]); }
  l_reg = l_reg * alpha + ps;
#define PK4(P, BASE, OUT) do { unsigned a0 = cvtpk(P[BASE + 0], P[BASE + 1]), a1 = cvtpk(P[BASE + 2], P[BASE + 3]);   \
    unsigned b0 = cvtpk(P[BASE + 4], P[BASE + 5]), b1 = cvtpk(P[BASE + 6], P[BASE + 7]);                              \
    auto r0 = __builtin_amdgcn_permlane32_swap(a0, b0, false, false); auto r1 = __builtin_amdgcn_permlane32_swap(a1, b1, false, false); \
    u32x4 w = {r0[0], r1[0], r0[1], r1[1]}; OUT = *reinterpret_cast<bf16x8*>(&w); } while (0)
  PK4(p0, 0, pa0); PK4(p0, 8, pa1); PK4(p1, 0, pa2); PK4(p1, 8, pa3);
#undef PK4
}
__device__ __forceinline__ void qkt(f32x16& p0, f32x16& p1, const bf16* Ks, const bf16x8* qr, int r32, int hi) {
  p0 = f32x16{}; p1 = f32x16{};
  for (int d0 = 0; d0 < 8; ++d0) { int cb = (d0 * 16 + hi * 8) * 2;
    bf16x8 b0 = *reinterpret_cast<const bf16x8*>((const char*)Ks + KSWZ(r32, cb));
    bf16x8 b1 = *reinterpret_cast<const bf16x8*>((const char*)Ks + KSWZ(32 + r32, cb));
    p0 = __builtin_amdgcn_mfma_f32_32x32x16_bf16(b0, qr[d0], p0, 0, 0, 0);
    p1 = __builtin_amdgcn_mfma_f32_32x32x16_bf16(b1, qr[d0], p1, 0, 0, 0); }
}
__device__ __forceinline__ int v_st(int k, int c) { const int kk = (k & ~0xC) | ((k & 4) << 1) | ((k & 8) >> 1); return ((kk >> 3) * 4 + (c >> 5)) * 512 + ((kk & 7) * 32 + (c & 31)) * 2; }
__device__ __forceinline__ int v_rd_base(int lane) { return ((lane & 3) << 3) | (((lane >> 2) & 3) << 6) | (((lane >> 4) & 1) << 5) | (((lane >> 5) & 1) << 8); }
constexpr int v_rd_off(int d0, int ks, int half) { return d0 * 512 + ks * 4096 + half * 2048; }
template <int OFF> __device__ __forceinline__ s16x4 tr_read(int vb) {
  s16x4 r; asm volatile("ds_read_b64_tr_b16 %0, %1 offset:%2" : "=&v"(r) : "v"(vb), "i"(OFF) : "memory"); return r;
}
template <int D0> __device__ __forceinline__ void pv_one(f32x16& od, int vb, bf16x8 pa0, bf16x8 pa1, bf16x8 pa2, bf16x8 pa3) {
  const s16x4 l0 = tr_read<v_rd_off(D0, 0, 0)>(vb), h0 = tr_read<v_rd_off(D0, 0, 1)>(vb), l1 = tr_read<v_rd_off(D0, 1, 0)>(vb), h1 = tr_read<v_rd_off(D0, 1, 1)>(vb);
  const s16x4 l2 = tr_read<v_rd_off(D0, 2, 0)>(vb), h2 = tr_read<v_rd_off(D0, 2, 1)>(vb), l3 = tr_read<v_rd_off(D0, 3, 0)>(vb), h3 = tr_read<v_rd_off(D0, 3, 1)>(vb);
  asm volatile("s_waitcnt lgkmcnt(0)" ::: "memory"); SBAR();
#define PK(L, H) (bf16x8){L[0], L[1], L[2], L[3], H[0], H[1], H[2], H[3]}
  od = __builtin_amdgcn_mfma_f32_32x32x16_bf16(pa0, PK(l0, h0), od, 0, 0, 0);
  od = __builtin_amdgcn_mfma_f32_32x32x16_bf16(pa1, PK(l1, h1), od, 0, 0, 0);
  od = __builtin_amdgcn_mfma_f32_32x32x16_bf16(pa2, PK(l2, h2), od, 0, 0, 0);
  od = __builtin_amdgcn_mfma_f32_32x32x16_bf16(pa3, PK(l3, h3), od, 0, 0, 0);
#undef PK
}
__device__ __forceinline__ void pv_d0(f32x16* o, int vb, bf16x8 pa0, bf16x8 pa1, bf16x8 pa2, bf16x8 pa3) {
  pv_one<0>(o[0], vb, pa0, pa1, pa2, pa3); pv_one<1>(o[1], vb, pa0, pa1, pa2, pa3); pv_one<2>(o[2], vb, pa0, pa1, pa2, pa3); pv_one<3>(o[3], vb, pa0, pa1, pa2, pa3);
}
__device__ __forceinline__ void attn_unit(const bf16* Qb, const bf16* __restrict__ K0, const bf16* __restrict__ V0, int n0, const bf16* __restrict__ K1, const bf16* __restrict__ V1, int ntot, bf16* Ob, char* lds) {
  int tid = threadIdx.x; asm volatile("" : "+v"(tid));
  const int wid = tid >> 6, lane = tid & 63, r32 = lane & 31, hi = lane >> 5;
  bf16* V_lds = (bf16*)lds; bf16* K_lds = (bf16*)(lds + 2 * SHM_V);
  float* ws = (float*)(lds + 2 * SHM_V + 2 * SHM_K) + wid * 64; float* li_l = ws; float* al_l = ws + 32;
  float m_reg = -1e30f, l_reg = 0; f32x16 o[4] = {}; bf16x8 qr[8];
  const bf16* Qw = Qb + (long)(wid * QBLK + r32) * LDQ + hi * 8;
#pragma unroll
  for (int d0 = 0; d0 < 8; ++d0) qr[d0] = *reinterpret_cast<const bf16x8*>(Qw + d0 * 16);
  const int sr = tid >> 4, sc = (tid & 15) * 8, vst0 = v_st(sr, sc), vst1 = v_st(32 + sr, sc);
  const int vb0 = (int)(uintptr_t)V_lds + v_rd_base(lane);
  const unsigned soff = (unsigned)(sr * LDK + sc) * 2u;
  struct { bf16x8 vs0, vs1, ks0, ks1; } sr_[2];
#define SLOAD(i, k0) do { const int k0_ = (k0); const char* kp_ = (const char*)(k0_ < n0 ? K0 + (long)k0_ * LDK : K1 + (long)(k0_ - n0) * LDK); \
    const char* vp_ = (const char*)(k0_ < n0 ? V0 + (long)k0_ * LDK : V1 + (long)(k0_ - n0) * LDK); \
    sr_[i].vs0 = *reinterpret_cast<const bf16x8*>(vp_ + soff); sr_[i].vs1 = *reinterpret_cast<const bf16x8*>(vp_ + 32 * LDK * 2 + soff); \
    sr_[i].ks0 = *reinterpret_cast<const bf16x8*>(kp_ + soff); sr_[i].ks1 = *reinterpret_cast<const bf16x8*>(kp_ + 32 * LDK * 2 + soff); } while (0)
#define SWRITE(b, i) do { *(bf16x8*)((char*)V_lds + (b) * SHM_V + vst0) = sr_[i].vs0;          \
    *(bf16x8*)((char*)V_lds + (b) * SHM_V + vst1) = sr_[i].vs1; int kc = sc * 2;               \
    *(bf16x8*)((char*)K_lds + (b) * SHM_K + KSWZ(sr, kc)) = sr_[i].ks0;                       \
    *(bf16x8*)((char*)K_lds + (b) * SHM_K + KSWZ(32 + sr, kc)) = sr_[i].ks1; } while (0)
#define SWAIT() asm volatile("s_waitcnt vmcnt(4)" ::: "memory")
#define RESC(a) do { if (__any((a) < 1.f)) { if (hi == 0) al_l[r32] = (a); asm volatile("s_waitcnt lgkmcnt(0)" ::: "memory"); \
    for (int d = 0; d < 4; ++d) for (int r = 0; r < 16; ++r) o[d][r] *= al_l[crow(r, hi)]; } } while (0)
  f32x16 pA0, pA1, pB0, pB1; float mnA, mnB, alA, alB; bf16x8 pa0, pa1, pa2, pa3; const int NT = ntot / KVBLK;
  constexpr int SE = 0, SO = 1;
  SLOAD(SE, 0); asm volatile("s_waitcnt vmcnt(0)" ::: "memory"); SWRITE(0, SE); __syncthreads();
  qkt(pA0, pA1, K_lds, qr, r32, hi); partialSM(pA0, pA1, m_reg, mnA, alA);
  SLOAD(SO, KVBLK); if (2 < NT) SLOAD(SE, 2 * KVBLK);
  SWAIT(); SWRITE(1, SO); __syncthreads();
  for (int j = 1; j + 1 < NT; j += 2) {
    SBAR(); qkt(pB0, pB1, (bf16*)((char*)K_lds + SHM_K), qr, r32, hi);
    finishSM(pA0, pA1, alA, l_reg, pa0, pa1, pa2, pa3); SBAR();
    SLOAD(SO, (j + 2) * KVBLK); SBAR();
    pv_d0(o, vb0, pa0, pa1, pa2, pa3); partialSM(pB0, pB1, m_reg, mnB, alB);
    __syncthreads(); SWAIT(); SWRITE(0, SE);
    RESC(alB); __syncthreads();
    SBAR(); qkt(pA0, pA1, K_lds, qr, r32, hi);
    finishSM(pB0, pB1, alB, l_reg, pa0, pa1, pa2, pa3); SBAR();
    if (j + 3 < NT) SLOAD(SE, (j + 3) * KVBLK); SBAR();
    pv_d0(o, vb0 + (int)SHM_V, pa0, pa1, pa2, pa3); partialSM(pA0, pA1, m_reg, mnA, alA);
    __syncthreads(); SWAIT(); SWRITE(1, SO);
    RESC(alA); __syncthreads();
  }
  SBAR(); qkt(pB0, pB1, (bf16*)((char*)K_lds + SHM_K), qr, r32, hi);
  finishSM(pA0, pA1, alA, l_reg, pa0, pa1, pa2, pa3); SBAR();
  pv_d0(o, vb0, pa0, pa1, pa2, pa3); partialSM(pB0, pB1, m_reg, mnB, alB);
  __syncthreads(); RESC(alB);
  finishSM(pB0, pB1, alB, l_reg, pa0, pa1, pa2, pa3); SBAR();
  pv_d0(o, vb0 + (int)SHM_V, pa0, pa1, pa2, pa3);
  if (hi == 0) li_l[r32] = l_reg; asm volatile("s_waitcnt lgkmcnt(0)" ::: "memory");
  float rli[16];
#pragma unroll
  for (int r = 0; r < 16; ++r) rli[r] = __builtin_amdgcn_rcpf(li_l[crow(r, hi)]);
  __syncthreads();
  unsigned short* stg = (unsigned short*)lds + wid * (QBLK * D);
#pragma unroll
  for (int r = 0; r < 16; ++r) { const int orow = crow(r, hi);
#pragma unroll
    for (int d0 = 0; d0 < 4; ++d0) stg[orow * D + d0 * 32 + r32] = (unsigned short)(cvtpk(o[d0][r] * rli[r], 0.f) & 0xffffu); }
  asm volatile("s_waitcnt lgkmcnt(0)" ::: "memory");
  bf16* Ow = Ob + (long)(wid * QBLK) * LDO;
#pragma unroll
  for (int i = 0; i < 8; ++i) { const int row = i * 4 + (lane >> 4), ch = lane & 15; const u32x4 v = *(const u32x4*)(stg + row * D + ch * 8); *(u32x4*)(Ow + (long)row * LDO + ch * 8) = v; }
  __syncthreads();
#undef SLOAD
#undef SWRITE
#undef SWAIT
#undef RESC
}


template <int D0> __device__ __forceinline__ void pv_rd(s16x4 (&l)[4], s16x4 (&h)[4], int vb) {
  l[0] = tr_read<v_rd_off(D0, 0, 0)>(vb); h[0] = tr_read<v_rd_off(D0, 0, 1)>(vb); l[1] = tr_read<v_rd_off(D0, 1, 0)>(vb); h[1] = tr_read<v_rd_off(D0, 1, 1)>(vb);
  l[2] = tr_read<v_rd_off(D0, 2, 0)>(vb); h[2] = tr_read<v_rd_off(D0, 2, 1)>(vb); l[3] = tr_read<v_rd_off(D0, 3, 0)>(vb); h[3] = tr_read<v_rd_off(D0, 3, 1)>(vb);
}
__device__ __forceinline__ void pv_mm(f32x16& od, const s16x4 (&l)[4], const s16x4 (&h)[4], bf16x8 pa0, bf16x8 pa1, bf16x8 pa2, bf16x8 pa3) {
#define PK(L, H) (bf16x8){L[0], L[1], L[2], L[3], H[0], H[1], H[2], H[3]}
  od = __builtin_amdgcn_mfma_f32_32x32x16_bf16(pa0, PK(l[0], h[0]), od, 0, 0, 0);
  od = __builtin_amdgcn_mfma_f32_32x32x16_bf16(pa1, PK(l[1], h[1]), od, 0, 0, 0);
  od = __builtin_amdgcn_mfma_f32_32x32x16_bf16(pa2, PK(l[2], h[2]), od, 0, 0, 0);
  od = __builtin_amdgcn_mfma_f32_32x32x16_bf16(pa3, PK(l[3], h[3]), od, 0, 0, 0);
#undef PK
}
__device__ __forceinline__ void pv_pipe(f32x16* o, int vb, s16x4 (&la)[4], s16x4 (&ha)[4], bf16x8 pa0, bf16x8 pa1, bf16x8 pa2, bf16x8 pa3) {
  s16x4 lb[4], hb[4];
  pv_rd<1>(lb, hb, vb); asm volatile("s_waitcnt lgkmcnt(8)" ::: "memory"); SBAR(); pv_mm(o[0], la, ha, pa0, pa1, pa2, pa3); SBAR();
  pv_rd<2>(la, ha, vb); asm volatile("s_waitcnt lgkmcnt(8)" ::: "memory"); SBAR(); pv_mm(o[1], lb, hb, pa0, pa1, pa2, pa3); SBAR();
  pv_rd<3>(lb, hb, vb); asm volatile("s_waitcnt lgkmcnt(8)" ::: "memory"); SBAR(); pv_mm(o[2], la, ha, pa0, pa1, pa2, pa3); SBAR();
  asm volatile("s_waitcnt lgkmcnt(0)" ::: "memory"); SBAR(); pv_mm(o[3], lb, hb, pa0, pa1, pa2, pa3); SBAR();
}

template <int OFF> __device__ __forceinline__ bf16x8 k_read(int addr) { bf16x8 r; asm volatile("ds_read_b128 %0, %1 offset:%2" : "=&v"(r) : "v"(addr), "i"(OFF) : "memory"); return r; }
template <int G> __device__ __forceinline__ void qk_rd(bf16x8 (&f)[4], const int (&ka)[4]) {
  f[0] = k_read<(G >> 1) * 128>(ka[(2 * G) & 3]);     f[1] = k_read<(G >> 1) * 128 + 8192>(ka[(2 * G) & 3]);
  f[2] = k_read<(G >> 1) * 128>(ka[(2 * G + 1) & 3]); f[3] = k_read<(G >> 1) * 128 + 8192>(ka[(2 * G + 1) & 3]);
}
template <int G> __device__ __forceinline__ void qk_mm(f32x16& p0, f32x16& p1, const bf16x8 (&f)[4], const bf16x8* qr) {
  if constexpr (G == 0) { const f32x16 z = {}; p0 = __builtin_amdgcn_mfma_f32_32x32x16_bf16(f[0], qr[0], z, 0, 0, 0); p1 = __builtin_amdgcn_mfma_f32_32x32x16_bf16(f[1], qr[0], z, 0, 0, 0); }
  else { p0 = __builtin_amdgcn_mfma_f32_32x32x16_bf16(f[0], qr[2 * G], p0, 0, 0, 0); p1 = __builtin_amdgcn_mfma_f32_32x32x16_bf16(f[1], qr[2 * G], p1, 0, 0, 0); }
  p0 = __builtin_amdgcn_mfma_f32_32x32x16_bf16(f[2], qr[2 * G + 1], p0, 0, 0, 0); p1 = __builtin_amdgcn_mfma_f32_32x32x16_bf16(f[3], qr[2 * G + 1], p1, 0, 0, 0);
}
__device__ __forceinline__ void qkt_pipe(f32x16& p0, f32x16& p1, const int (&kb)[4], int kslot, const bf16x8* qr) {
  int ka[4]; ka[0] = kb[0] + kslot; ka[1] = kb[1] + kslot; ka[2] = kb[2] + kslot; ka[3] = kb[3] + kslot;
  bf16x8 fa[4], fb[4];
  qk_rd<0>(fa, ka); qk_rd<1>(fb, ka); asm volatile("s_waitcnt lgkmcnt(4)" ::: "memory"); SBAR(); qk_mm<0>(p0, p1, fa, qr); SBAR();
  qk_rd<2>(fa, ka); asm volatile("s_waitcnt lgkmcnt(4)" ::: "memory"); SBAR(); qk_mm<1>(p0, p1, fb, qr); SBAR();
  qk_rd<3>(fb, ka); asm volatile("s_waitcnt lgkmcnt(4)" ::: "memory"); SBAR(); qk_mm<2>(p0, p1, fa, qr); SBAR();
  asm volatile("s_waitcnt lgkmcnt(0)" ::: "memory"); SBAR(); qk_mm<3>(p0, p1, fb, qr); SBAR();
}
constexpr size_t SHM_ATTN2 = 3 * SHM_V + 3 * SHM_K + NW * 64 * 4;
__device__ __forceinline__ void softmaxY(f32x16& p0, f32x16& p1, float& m_reg, float& l_reg, float& alpha, bf16x8& pa0, bf16x8& pa1, bf16x8& pa2, bf16x8& pa3) {
  float mn; partialSM(p0, p1, m_reg, mn, alpha); finishSM(p0, p1, alpha, l_reg, pa0, pa1, pa2, pa3);
}
__device__ __forceinline__ void attn_unit2(const bf16* Qb, const bf16* __restrict__ K0, const bf16* __restrict__ V0, int n0, const bf16* __restrict__ K1, const bf16* __restrict__ V1, int ntot, bf16* Ob, char* lds) {
  int tid = threadIdx.x; asm volatile("" : "+v"(tid));
  const int wid = tid >> 6, lane = tid & 63, r32 = lane & 31, hi = lane >> 5, grp = __builtin_amdgcn_readfirstlane(wid >> 2);
  bf16* V_lds = (bf16*)lds; bf16* K_lds = (bf16*)(lds + 3 * SHM_V);
  float* ws = (float*)(lds + 3 * SHM_V + 3 * SHM_K) + wid * 64; float* li_l = ws; float* al_l = ws + 32;
  float m_reg = -1e30f, l_reg = 0; f32x16 o[4] = {}; bf16x8 qr[8];
  const bf16* Qw = Qb + (long)(wid * QBLK + r32) * LDQ + hi * 8;
#pragma unroll
  for (int d0 = 0; d0 < 8; ++d0) qr[d0] = *reinterpret_cast<const bf16x8*>(Qw + d0 * 16);
  const int sr = tid >> 4, sc = (tid & 15) * 8, vst0 = v_st(sr, sc), vst1 = v_st(32 + sr, sc);
  const int vb0 = (int)(uintptr_t)V_lds + v_rd_base(lane);
  const unsigned soff = (unsigned)(sr * LDK + sc) * 2u;
  bf16x8 vs0, vs1, ks0, ks1;
  int kb[4];
#pragma unroll
  for (int d = 0; d < 4; ++d) kb[d] = (int)(uintptr_t)K_lds + KSWZ(r32, d * 32 + hi * 16);
#define SLOAD2(k0) do { const int k0_ = (k0); const char* kp_ = (const char*)(k0_ < n0 ? K0 + (long)k0_ * LDK : K1 + (long)(k0_ - n0) * LDK); \
    const char* vp_ = (const char*)(k0_ < n0 ? V0 + (long)k0_ * LDK : V1 + (long)(k0_ - n0) * LDK); \
    vs0 = *reinterpret_cast<const bf16x8*>(vp_ + soff); vs1 = *reinterpret_cast<const bf16x8*>(vp_ + 32 * LDK * 2 + soff); \
    ks0 = *reinterpret_cast<const bf16x8*>(kp_ + soff); ks1 = *reinterpret_cast<const bf16x8*>(kp_ + 32 * LDK * 2 + soff); } while (0)
#define SWRITE2(slot) do { const int so_ = (slot) * (int)SHM_V; const int kc = sc * 2; \
    *(bf16x8*)((char*)V_lds + so_ + vst0) = vs0; *(bf16x8*)((char*)V_lds + so_ + vst1) = vs1; \
    *(bf16x8*)((char*)K_lds + so_ + KSWZ(sr, kc)) = ks0; *(bf16x8*)((char*)K_lds + so_ + KSWZ(32 + sr, kc)) = ks1; } while (0)
#define XBAR() do { asm volatile("s_waitcnt lgkmcnt(0)" ::: "memory"); __builtin_amdgcn_s_barrier(); asm volatile("" ::: "memory"); SBAR(); } while (0)
#define RESC2(a) do { if (__any((a) < 1.f)) { if (hi == 0) al_l[r32] = (a); asm volatile("s_waitcnt lgkmcnt(0)" ::: "memory"); \
    for (int d = 0; d < 4; ++d) for (int r = 0; r < 16; ++r) o[d][r] *= al_l[crow(r, hi)]; } } while (0)
  const int NT = ntot / KVBLK;
  f32x16 p0, p1; float alpha; bf16x8 pa0, pa1, pa2, pa3;
  SLOAD2(0); asm volatile("s_waitcnt vmcnt(0)" ::: "memory"); SWRITE2(0); SLOAD2(KVBLK);
  XBAR();
  if (grp == 1) XBAR();
  SBAR(); qkt_pipe(p0, p1, kb, 0, qr);
  asm volatile("s_waitcnt vmcnt(0)" ::: "memory"); SWRITE2(1); if (2 < NT) SLOAD2(2 * KVBLK);
  XBAR();
  int sj = 0, sj1 = 1, sj2 = 2;
  for (int j = 0; j < NT; ++j) {
    softmaxY(p0, p1, m_reg, l_reg, alpha, pa0, pa1, pa2, pa3); RESC2(alpha);
    XBAR();
    { s16x4 la[4], ha[4]; const int vb = vb0 + sj * (int)SHM_V; pv_rd<0>(la, ha, vb);
      if (j + 1 < NT) qkt_pipe(p0, p1, kb, sj1 * (int)SHM_K, qr);
      pv_pipe(o, vb, la, ha, pa0, pa1, pa2, pa3); }
    if (j + 2 < NT) { asm volatile("s_waitcnt vmcnt(0)" ::: "memory"); SWRITE2(sj2); if (j + 3 < NT) SLOAD2((j + 3) * KVBLK); }
    XBAR();
    { const int t_ = sj; sj = sj1; sj1 = sj2; sj2 = t_; }
  }
  if (grp == 0) XBAR();
  if (hi == 0) li_l[r32] = l_reg; asm volatile("s_waitcnt lgkmcnt(0)" ::: "memory");
  float rli[16];
#pragma unroll
  for (int r = 0; r < 16; ++r) rli[r] = __builtin_amdgcn_rcpf(li_l[crow(r, hi)]);
  unsigned short* stg = (unsigned short*)lds + wid * (QBLK * D);
#pragma unroll
  for (int r = 0; r < 16; ++r) { const int orow = crow(r, hi);
#pragma unroll
    for (int d0 = 0; d0 < 4; ++d0) stg[orow * D + d0 * 32 + r32] = (unsigned short)(cvtpk(o[d0][r] * rli[r], 0.f) & 0xffffu); }
  asm volatile("s_waitcnt lgkmcnt(0)" ::: "memory");
  bf16* Ow = Ob + (long)(wid * QBLK) * LDO;
#pragma unroll
  for (int i = 0; i < 8; ++i) { const int row = i * 4 + (lane >> 4), ch = lane & 15; const u32x4 v = *(const u32x4*)(stg + row * D + ch * 8); *(u32x4*)(Ow + (long)row * LDO + ch * 8) = v; }
  XBAR();
#undef SLOAD2
#undef SWRITE2
#undef XBAR
#undef RESC2
}
#undef KSWZ
#undef SBAR
}
#define RLX_AGENT __ATOMIC_RELAXED, __HIP_MEMORY_SCOPE_AGENT
#define LDS_WAIT() asm volatile("s_waitcnt lgkmcnt(0)" ::: "memory")
#define VM_WAIT() asm volatile("s_waitcnt vmcnt(0)" ::: "memory")
__device__ __forceinline__ unsigned long long rt() { return __builtin_amdgcn_s_memrealtime(); }
#define XB_TMO      128
#define XB_XCNT(j)  (256  + 64 * (j))
#define XB_XSUB(j)  (1280 + 64 * (j))
#define XB_XGEN(j)  (2304 + 64 * (j))
#define XB_TOP      3328
#define XB_TOPGEN   3392
#define XCD_BAR_WORDS 3456
#define XB_SPIN_CAP (1u << 18)

__device__ __forceinline__ unsigned xb_ld(unsigned* p)              { return __hip_atomic_load(p, __ATOMIC_RELAXED, __HIP_MEMORY_SCOPE_AGENT); }
__device__ __forceinline__ unsigned xb_add(unsigned* p, unsigned v) { return __hip_atomic_fetch_add(p, v, __ATOMIC_RELAXED, __HIP_MEMORY_SCOPE_AGENT); }
__device__ __forceinline__ unsigned xb_xcc_id() { return (unsigned)__builtin_amdgcn_s_getreg((3 << 11) | 20) & 0xFu; }
#define XB_SPIN(cond, bar) do { unsigned _sp = 0; while (cond) { __builtin_amdgcn_s_sleep(1); \
    if ((++_sp & 255u) == 0u) { if (xb_ld(&(bar)[XB_TMO])) break; if (_sp > XB_SPIN_CAP) { atomicAdd(&(bar)[XB_TMO], 1u); break; } } } } while (0)

struct XcdBarrier {
    unsigned* bar; unsigned x;
    volatile LAS unsigned* st;
};

__device__ __forceinline__ XcdBarrier xcd_barrier_post(unsigned* bar, volatile LAS unsigned* st) {
    XcdBarrier b; b.bar = bar; b.x = xb_xcc_id(); b.st = st;
    if (threadIdx.x == 0) (void)xb_add(&bar[XB_XCNT(b.x)], 1u);
    return b;
}
__device__ __forceinline__ void xcd_barrier_complete(unsigned* bar, unsigned x, unsigned& nloc, unsigned& nx) {
    const unsigned G = gridDim.x * gridDim.y * gridDim.z;
    unsigned sum, cnt, mine, sp = 0u;
    for (;;) {
        sum = 0u; cnt = 0u; mine = 0u;
#pragma unroll
        for (unsigned j = 0; j < 16; ++j) { const unsigned c = xb_ld(&bar[XB_XCNT(j)]); sum += c; cnt += (c > 0u) ? 1u : 0u; mine = (j == x) ? c : mine; }
        if (sum == G) break;
        __builtin_amdgcn_s_sleep(1);
        if ((++sp & 255u) == 0u) { if (xb_ld(&bar[XB_TMO])) break; if (sp > XB_SPIN_CAP) { atomicAdd(&bar[XB_TMO], 1u); break; } }
    }
    nloc = mine > 0u ? mine : 1u; nx = cnt > 0u ? cnt : 1u;
}

__device__ __forceinline__ void xcd_barrier(const XcdBarrier& b) {
    asm volatile("s_waitcnt vmcnt(0)" ::: "memory");
    __syncthreads();
    if (threadIdx.x == 0) {
        unsigned* bar = b.bar;
        __builtin_amdgcn_s_waitcnt(0);
        unsigned nloc = b.st[0], nx = b.st[1];
        if (nloc == 0u) { xcd_barrier_complete(bar, b.x, nloc, nx); b.st[0] = nloc; b.st[1] = nx; }
        const unsigned old = xb_add(&bar[XB_XSUB(b.x)], 1u);
        const unsigned gen = old / nloc;
        if (old + 1u == (gen + 1u) * nloc) {
            __builtin_amdgcn_fence(__ATOMIC_RELEASE, "agent");
            asm volatile("s_waitcnt vmcnt(0)" ::: "memory");
            const unsigned og = xb_add(&bar[XB_TOP], 1u);
            const unsigned tg = og / nx;
            if (og + 1u == (tg + 1u) * nx) xb_add(&bar[XB_TOPGEN], 1u);
            else XB_SPIN(xb_ld(&bar[XB_TOPGEN]) == tg, bar);
            __builtin_amdgcn_fence(__ATOMIC_ACQUIRE, "agent");
            xb_add(&bar[XB_XGEN(b.x)], 1u);
            asm volatile("s_waitcnt vmcnt(0)" ::: "memory");
        } else {
            XB_SPIN(xb_ld(&bar[XB_XGEN(b.x)]) == gen, bar);
            __builtin_amdgcn_fence(__ATOMIC_ACQUIRE, "agent");
            asm volatile("s_waitcnt vmcnt(0)" ::: "memory");
        }
    }
    __syncthreads();
}
constexpr int RING_BYTES = 131072, XCH_OFF = RING_BYTES, XCH_BYTES = 8192, MISC_OFF = XCH_OFF + XCH_BYTES, LDS_BYTES = 147456;
constexpr int CW_BAR = 4096;
constexpr int PH_PREP = 0, PH_ADA = 1, PH_L0 = 2, PH_PER_LAYER = 8, PH_FINAL = PH_L0 + DEPTH * PH_PER_LAYER, PH_COUNT = PH_FINAL + 1;

__device__ __forceinline__ void ph_attention(unsigned char* ws, int layer, int vcu, char* lds) {
    bf16* QO = (bf16*)(ws + WS_Q); const bf16* KB = (const bf16*)(ws + WS_K); const bf16* VB = (const bf16*)(ws + WS_V);
    const bf16* KC = (const bf16*)(ws + WS_KC); const bf16* VC = (const bf16*)(ws + WS_VC);
    const int xcd = vcu >> 5, j = vcu & 31;
    for (int i = 0; i < 6; ++i) {
        int b, head, kvh, n0, ntot; size_t row0, qrow; const bf16 *k1, *v1;
        if (i < 4) { const int grp = xcd * 4 + i; b = grp >> 2; kvh = grp & 3; head = kvh * 4 + (j >> 3); row0 = (size_t)NCTX + (size_t)b * 2048; qrow = row0 + (size_t)(j & 7) * 256; n0 = 2048; ntot = 2304;
                     k1 = KC + (size_t)((layer * 8 + b) * 256) * DKV + kvh * HD; v1 = VC + (size_t)((layer * 8 + b) * 256) * DKV + kvh * HD; }
        else { const int uc = vcu * 2 + (i - 4); b = uc >> 4; head = uc & 15; kvh = head >> 2; row0 = (size_t)b * 256; qrow = row0; n0 = 256; ntot = 256; k1 = KB; v1 = VB; }
        bf16* q = QO + qrow * DM + head * HD;
        att::attn_unit2(q, KB + row0 * DKV + kvh * HD, VB + row0 * DKV + kvh * HD, n0, k1, v1, ntot, q, lds);
    }
}

struct MkArgs { Params p; int ph_lo, ph_hi; };
__global__ void __launch_bounds__(512, 2) mk_fwd(MkArgs a) {
    extern __shared__ __attribute__((aligned(16))) unsigned char lds_raw[];
    LAS unsigned char* lds = (LAS unsigned char*)lds_raw;
    const Params& p = a.p;
    const int wave = __builtin_amdgcn_readfirstlane((int)threadIdx.x >> 6);
    const int G = gridDim.x, bx = blockIdx.x, vcu = (bx % 8) * (G / 8) + bx / 8;
    if (G != 256) return;
    volatile LAS unsigned* MISC = (volatile LAS unsigned*)(lds + MISC_OFF);
    if (threadIdx.x < 32) MISC[threadIdx.x] = 0u;
    __syncthreads();
    XcdBarrier bar = xcd_barrier_post((unsigned*)(p.ws + WS_CTL) + CW_BAR, MISC + 8);
    const int lo = a.ph_lo, hi = a.ph_hi;
#define PHASE_VARS int tid_l = threadIdx.x, vcu_l = vcu; asm volatile("" : "+v"(tid_l), "+s"(vcu_l)); const int lane = tid_l & 63, gt = vcu_l * 512 + tid_l, gw = vcu_l * 8 + wave, ngw = G * 8, ngt = G * 512; \
                   (void)lane; (void)gt; (void)gw; (void)ngw; (void)ngt; \
                   const __attribute__((address_space(4))) MkArgs* ap_ = (const __attribute__((address_space(4))) MkArgs*)__builtin_amdgcn_kernarg_segment_ptr(); asm volatile("" : "+s"(ap_)); \
                   Params q; q.x_prompt = ap_->p.x_prompt; q.x_sample = ap_->p.x_sample; q.cache_k = ap_->p.cache_k; q.cache_v = ap_->p.cache_v; q.c = ap_->p.c; q.c_ctx = ap_->p.c_ctx; q.w_ada = ap_->p.w_ada; q.b_ada = ap_->p.b_ada; q.norm1 = ap_->p.norm1; q.w_in = ap_->p.w_in; q.q_gain = ap_->p.q_gain; q.k_gain = ap_->p.k_gain; q.conv_w = ap_->p.conv_w; q.conv_b = ap_->p.conv_b; q.w_a = ap_->p.w_a; q.w_b = ap_->p.w_b; q.w_o = ap_->p.w_o; q.norm2 = ap_->p.norm2; q.w_gate = ap_->p.w_gate; q.w_up = ap_->p.w_up; q.w_down = ap_->p.w_down; q.norm_f = ap_->p.norm_f; q.out = ap_->p.out; q.ws = ap_->p.ws; unsigned char* ws = q.ws; float* outp = q.out
#define IN(k) (lo <= (k) && (k) < hi)
#define SEAM(k) do { if ((k) + 1 < hi) xcd_barrier(bar); } while (0)

    if (IN(PH_PREP)) {
        PHASE_VARS;
        ph_ada_partials(q, (LAS float*)lds, gw, ngw, lane, tid_l, 512);
        ph_misc_prep(q, gt, ngt);
        __syncthreads();
        ph_weights(q, (LAS float*)lds + wave * (64 * 33), gw, ngw, lane);
        SEAM(PH_PREP);
    }
    if (IN(PH_ADA)) { PHASE_VARS; ph_ada_reduce(q, gt, ngt); SEAM(PH_ADA); }

    for (int l = 0; l < DEPTH; ++l) {
        const int pb = PH_L0 + l * PH_PER_LAYER;
        if (IN(pb + 0)) { PHASE_VARS; ph_norm(q, l, 0, gw, ngw, lane); SEAM(pb + 0); }
        if (IN(pb + 1)) {
            PHASE_VARS; const unsigned char* wl = ws + WS_W + (size_t)l * W_LAYER;
            pg8::Gemm g{(const bf16*)(ws + WS_HB), (const bf16*)(wl + W_IN), MTOK, NIN, DM}; pg8::StaticOrder S; S.init(MTOK, NIN, G, bx);
            pg8::EpiIn E{ws, outp, q.q_gain + l * HD, q.k_gain + l * HD, (LAS float*)(lds + XCH_OFF), l};
            if (wave < 4) pg8::gemm_phase<pg8::EpiIn, pg8::StaticOrder, true, true, 0>(lds, g, S, E); else pg8::gemm_phase<pg8::EpiIn, pg8::StaticOrder, true, true, 1>(lds, g, S, E);
            SEAM(pb + 1);
        }
        if (IN(pb + 2)) { PHASE_VARS; ph_conv(q, l, gt, ngt); ph_attention(ws, l, vcu, (char*)lds_raw); SEAM(pb + 2); }
        if (IN(pb + 3)) {
            PHASE_VARS; const unsigned char* wl = ws + WS_W + (size_t)l * W_LAYER;
            pg8::Gemm2 g{(const bf16*)(ws + WS_CVB), (const bf16*)(wl + W_A), (const bf16*)(ws + WS_Q), (const bf16*)(wl + W_B), DCONV / 64, DM / 64, DM}; pg8::StaticOrder S; S.init(MTOK, DM, G, bx);
            pg8::MidR Mm{(const bf16*)(ws + WS_R)}; pg8::EpiB2 E{(const bf16*)(ws + WS_SB), (bf16*)(ws + WS_HB)};
            if (wave < 4) pg8::gemm_phase_ab<pg8::MidR, pg8::EpiB2, pg8::StaticOrder, true, true, 0>(lds, g, S, Mm, E); else pg8::gemm_phase_ab<pg8::MidR, pg8::EpiB2, pg8::StaticOrder, true, true, 1>(lds, g, S, Mm, E);
            SEAM(pb + 3);
        }
        if (IN(pb + 4)) {
            PHASE_VARS; const unsigned char* wl = ws + WS_W + (size_t)l * W_LAYER;
            pg8::Gemm g{(const bf16*)(ws + WS_HB), (const bf16*)(wl + W_O), MTOK, DM, DM}; pg8::StaticOrder S; S.init(MTOK, DM, G, bx);
            pg8::EpiRes E{(bf16*)(ws + WS_X), (const float*)(ws + WS_MODS) + (size_t)l * NMOD * 6 * DM, 2, l == 0 ? q.x_prompt : nullptr, l == 0 ? q.x_sample : nullptr};
            if (wave < 4) pg8::gemm_phase<pg8::EpiRes, pg8::StaticOrder, true, true, 0>(lds, g, S, E); else pg8::gemm_phase<pg8::EpiRes, pg8::StaticOrder, true, true, 1>(lds, g, S, E);
            SEAM(pb + 4);
        }
        if (IN(pb + 5)) { PHASE_VARS; ph_norm(q, l, 1, gw, ngw, lane); SEAM(pb + 5); }
        if (IN(pb + 6)) {
            PHASE_VARS; const unsigned char* wl = ws + WS_W + (size_t)l * W_LAYER;
            pg8::Gemm g{(const bf16*)(ws + WS_HB), (const bf16*)(wl + W_GU), MTOK, NGU, DM}; pg8::StaticOrder S; S.init(MTOK, NGU, G, bx);
            pg8::EpiGU E{(bf16*)(ws + WS_ACT)};
            if (wave < 4) pg8::gemm_phase<pg8::EpiGU, pg8::StaticOrder, true, true, 0>(lds, g, S, E); else pg8::gemm_phase<pg8::EpiGU, pg8::StaticOrder, true, true, 1>(lds, g, S, E);
            if (l + 1 < DEPTH && bx >= 128) ph_weights_tail(q, (LAS float*)lds + wave * (64 * 33), l + 1, (bx - 128) * 8 + wave, 1024, lane);
            SEAM(pb + 6);
        }
        if (IN(pb + 7)) {
            PHASE_VARS; const unsigned char* wl = ws + WS_W + (size_t)l * W_LAYER;
            pg8::Gemm g{(const bf16*)(ws + WS_ACT), (const bf16*)(wl + W_D), MTOK, DM, DFF}; pg8::StaticOrder S; S.init(MTOK, DM, G, bx);
            pg8::EpiRes E{(bf16*)(ws + WS_X), (const float*)(ws + WS_MODS) + (size_t)l * NMOD * 6 * DM, 5, nullptr, nullptr};
            if (wave < 4) pg8::gemm_phase<pg8::EpiRes, pg8::StaticOrder, true, true, 0>(lds, g, S, E); else pg8::gemm_phase<pg8::EpiRes, pg8::StaticOrder, true, true, 1>(lds, g, S, E);
            SEAM(pb + 7);
        }
    }
    if (IN(PH_FINAL)) { PHASE_VARS; ph_final_norm(q, gw, ngw, lane); }
#undef IN
#undef SEAM
#undef PHASE_VARS
}
static Params make_params(void* const* d_in, void* d_out, void* d_ws) {
    Params p{};
    p.x_prompt = (const float*)d_in[0]; p.x_sample = (const float*)d_in[1]; p.cache_k = (const float*)d_in[2]; p.cache_v = (const float*)d_in[3];
    p.c = (const float*)d_in[4]; p.c_ctx = (const float*)d_in[5]; p.w_ada = (const float*)d_in[6]; p.b_ada = (const float*)d_in[7]; p.norm1 = (const float*)d_in[8];
    p.w_in = (const float*)d_in[9]; p.q_gain = (const float*)d_in[10]; p.k_gain = (const float*)d_in[11]; p.conv_w = (const float*)d_in[12]; p.conv_b = (const float*)d_in[13];
    p.w_a = (const float*)d_in[14]; p.w_b = (const float*)d_in[15]; p.w_o = (const float*)d_in[16]; p.norm2 = (const float*)d_in[17];
    p.w_gate = (const float*)d_in[18]; p.w_up = (const float*)d_in[19]; p.w_down = (const float*)d_in[20]; p.norm_f = (const float*)d_in[21];
    p.out = (float*)d_out; p.ws = (unsigned char*)d_ws; return p;
}
static void mk_launch(const Params& p, int lo, int hi, int grid, hipStream_t stream) {
    (void)hipMemsetAsync(p.ws + WS_CTL, 0, CTL_ZERO_BYTES, stream);
    MkArgs a{}; a.p = p; a.ph_lo = lo; a.ph_hi = hi;
    hipLaunchKernelGGL(mk_fwd, dim3(grid), dim3(512), LDS_BYTES, stream, a);
    const hipError_t le = hipPeekAtLastError();
    if (le != hipSuccess) fprintf(stderr, "kernel_launch: mk_fwd launch failed: %s (grid %d)\n", hipGetErrorName(le), grid);
}
extern "C" void kernel_launch(void* const* d_in, const int* in_sizes, int n_in, void* d_out, int out_size, void* d_ws, size_t ws_size, hipStream_t stream) {
    static int grid = 0;
    if (grid == 0) {
        if (n_in != 22 || out_size != 83886080 || ws_size < WS_END) { fprintf(stderr, "kernel_launch: unexpected shapes: n_in %d out %d ws %zu (need %zu)\n", n_in, out_size, ws_size, (size_t)WS_END); grid = -1; return; }
        int dev = 0, cus = 0, per_cu = 0;
        if (hipGetDevice(&dev) != hipSuccess || hipDeviceGetAttribute(&cus, hipDeviceAttributeMultiprocessorCount, dev) != hipSuccess) { grid = -1; return; }
        if (hipFuncSetAttribute((const void*)mk_fwd, hipFuncAttributeMaxDynamicSharedMemorySize, LDS_BYTES) != hipSuccess) { fprintf(stderr, "kernel_launch: hipFuncSetAttribute failed\n"); grid = -1; return; }
        if (hipOccupancyMaxActiveBlocksPerMultiprocessor(&per_cu, (const void*)mk_fwd, 512, LDS_BYTES) != hipSuccess || per_cu < 1) fprintf(stderr, "kernel_launch: occupancy query says %d\n", per_cu);
        (void)hipGetLastError();
        grid = cus;
    }
    if (grid < 0) return;
    const Params p = make_params(d_in, d_out, d_ws);
    mk_launch(p, 0, PH_COUNT, grid, stream);
}
```
